# Optimizing an MI355X kernel written in HIP

```python
import jax, jax.numpy as jnp
from jax import lax
import numpy as np

D_MODEL = 1024
BATCH = 8
SEQ = 2048
DEPTH = 1
DEC_BATCH = 128
DEC_SEQ = 4
PAST_LEN = 16384
PAGE_SIZE = 128

CONV_CH = D_MODEL // 2
CONV_K = 31
RET_HEADS = 8
RET_W = D_MODEL - CONV_CH
RET_DK = RET_W // RET_HEADS
RET_DV = RET_W // RET_HEADS
D_IN = 2 * CONV_CH + 4 * RET_W
D_FF = 4 * D_MODEL
RET_CHUNK = 128
ROPE_THETA = 10000.0
EPS = 1e-6
N_MOD = 6

kernel_name = 'hybrid_conformer_retention_adaln_step'


def rmsnorm(x, g):
    xf = x.astype(jnp.float32)
    y = xf * lax.rsqrt(jnp.mean(xf * xf, axis=-1, keepdims=True) + EPS)
    return (y * g.astype(jnp.float32)).astype(x.dtype)


def layernorm(x, g, b):
    xf = x.astype(jnp.float32)
    mu = jnp.mean(xf, axis=-1, keepdims=True)
    var = jnp.mean(jnp.square(xf - mu), axis=-1, keepdims=True)
    y = (xf - mu) * lax.rsqrt(var + EPS) * g.astype(jnp.float32) + b.astype(jnp.float32)
    return y.astype(x.dtype)


def rotary(x, pos):
    half = x.shape[-1] // 2
    inv = ROPE_THETA ** (-jnp.arange(half, dtype=jnp.float32) / half)
    ang = pos.astype(jnp.float32)[:, None] * inv[None, :]
    cos = jnp.cos(ang)[None, :, None, :]
    sin = jnp.sin(ang)[None, :, None, :]
    xf = x.astype(jnp.float32)
    x1, x2 = xf[..., :half], xf[..., half:]
    return jnp.concatenate([x1 * cos - x2 * sin, x1 * sin + x2 * cos], axis=-1).astype(x.dtype)


def retention_log_decay():
    return jnp.log1p(-jnp.exp2(-5.0 - jnp.arange(RET_HEADS, dtype=jnp.float32)))


def retention_chunk(S, qkv):
    q, k, v = qkv
    C = q.shape[2]
    log_g = retention_log_decay()
    idx = jnp.arange(C, dtype=jnp.float32)
    diff = idx[:, None] - idx[None, :]
    decay = jnp.where(diff >= 0, jnp.exp(log_g[:, None, None] * jnp.maximum(diff, 0.0)), 0.0)
    scores = jnp.einsum('bhid,bhjd->bhij', q, k) * decay[None]
    o_intra = jnp.einsum('bhij,bhjv->bhiv', scores, v)
    q_dec = q * jnp.exp(log_g[:, None] * (idx[None, :] + 1.0))[None, :, :, None]
    o_cross = jnp.einsum('bhid,bhdv->bhiv', q_dec, S)
    k_dec = k * jnp.exp(log_g[:, None] * (C - 1.0 - idx[None, :]))[None, :, :, None]
    S_new = jnp.exp(log_g * C)[None, :, None, None] * S + jnp.einsum('bhjd,bhjv->bhdv', k_dec, v)
    return S_new, o_intra + o_cross


def retention_scan(q, k, v, S0):
    B, L, H, _ = q.shape
    C = RET_CHUNK if L % RET_CHUNK == 0 else L
    n = L // C

    def to_chunks(t):
        return t.astype(jnp.float32).reshape(B, n, C, H, t.shape[-1]).transpose(1, 0, 3, 2, 4)

    S_fin, o = lax.scan(retention_chunk, S0.astype(jnp.float32), (to_chunks(q), to_chunks(k), to_chunks(v)))
    o = o.transpose(1, 0, 3, 2, 4).reshape(B, L, H, RET_DV)
    return o, S_fin


def decoder_layer(x, c, conv_hist, ret_state, pos0, w_ada, b_ada, g_mix, w_in, conv_w, conv_b,
                  conv_ln_g, conv_ln_b, ret_ln_g, ret_ln_b, w_out, g_ffn, w_ff1, w_ff2):
    B, L, _ = x.shape
    mod = jax.nn.silu(c) @ w_ada + b_ada
    sh1, sc1, gt1, sh2, sc2, gt2 = [m[:, None, :] for m in jnp.split(mod, N_MOD, axis=-1)]

    h = rmsnorm(x, g_mix) * (1 + sc1) + sh1
    proj = h @ w_in
    cuts = [CONV_CH, 2 * CONV_CH, 2 * CONV_CH + RET_W, 2 * CONV_CH + 2 * RET_W, 2 * CONV_CH + 3 * RET_W]
    a, b, q, k, v, g = jnp.split(proj, cuts, axis=-1)

    u = a * jax.nn.sigmoid(b)
    u_ext = jnp.concatenate([conv_hist.astype(u.dtype), u], axis=1)
    dw = lax.conv_general_dilated(u_ext, conv_w[:, None, :].astype(u.dtype), window_strides=(1,),
                                  padding='VALID', dimension_numbers=('NWC', 'WIO', 'NWC'),
                                  feature_group_count=CONV_CH) + conv_b
    conv_out = jax.nn.silu(layernorm(dw, conv_ln_g, conv_ln_b))
    new_hist = u_ext[:, L:]

    pos = pos0 + jnp.arange(L)
    q = rotary(q.reshape(B, L, RET_HEADS, RET_DK), pos) * (RET_DK ** -0.5)
    k = rotary(k.reshape(B, L, RET_HEADS, RET_DK), pos)
    v = v.reshape(B, L, RET_HEADS, RET_DV)
    o, new_state = retention_scan(q, k, v, ret_state)
    o = layernorm(o, ret_ln_g.reshape(RET_HEADS, RET_DV), ret_ln_b.reshape(RET_HEADS, RET_DV))
    ret_out = o.astype(x.dtype).reshape(B, L, RET_W) * jax.nn.silu(g)

    mix = jnp.concatenate([conv_out, ret_out], axis=-1) @ w_out
    x = x + gt1 * mix

    h2 = rmsnorm(x, g_ffn) * (1 + sc2) + sh2
    ff = jnp.square(jax.nn.relu(h2 @ w_ff1)) @ w_ff2
    x = x + gt2 * ff
    return x, new_hist, new_state.astype(ret_state.dtype)


def setup_inputs(seed: int = 0) -> dict:
    key = jax.random.key(seed)
    ks = jax.random.split(key, 24)
    f32 = jnp.float32

    def nrm(k, shape, scale):
        return jax.random.normal(k, shape, f32) * scale

    return {
        'x_prompt': nrm(ks[0], (BATCH, SEQ, D_MODEL), 1.0),
        'x_sample': nrm(ks[1], (DEC_BATCH, DEC_SEQ, D_MODEL), 1.0),
        'cache_conv': nrm(ks[2], (DEPTH, DEC_BATCH, CONV_K - 1, CONV_CH), 0.5),
        'state_ret': nrm(ks[3], (DEPTH, DEC_BATCH, RET_HEADS, RET_DK, RET_DV), 1.0),
        'c_prompt': nrm(ks[4], (BATCH, D_MODEL), 1.0),
        'c_sample': nrm(ks[5], (DEC_BATCH, D_MODEL), 1.0),
        'w_ada': nrm(ks[6], (DEPTH, D_MODEL, N_MOD * D_MODEL), 0.5 * D_MODEL ** -0.5),
        'b_ada': nrm(ks[7], (DEPTH, N_MOD * D_MODEL), 0.02),
        'g_mix': 1.0 + nrm(ks[8], (DEPTH, D_MODEL), 0.02),
        'w_in': nrm(ks[9], (DEPTH, D_MODEL, D_IN), D_MODEL ** -0.5),
        'conv_w': nrm(ks[10], (DEPTH, CONV_K, CONV_CH), CONV_K ** -0.5),
        'conv_b': nrm(ks[11], (DEPTH, CONV_CH), 0.02),
        'conv_ln_g': 1.0 + nrm(ks[12], (DEPTH, CONV_CH), 0.02),
        'conv_ln_b': nrm(ks[13], (DEPTH, CONV_CH), 0.02),
        'ret_ln_g': 1.0 + nrm(ks[14], (DEPTH, RET_W), 0.02),
        'ret_ln_b': nrm(ks[15], (DEPTH, RET_W), 0.02),
        'w_out': nrm(ks[16], (DEPTH, D_MODEL, D_MODEL), D_MODEL ** -0.5),
        'g_ffn': 1.0 + nrm(ks[17], (DEPTH, D_MODEL), 0.02),
        'w_ff1': nrm(ks[18], (DEPTH, D_MODEL, D_FF), D_MODEL ** -0.5),
        'w_ff2': nrm(ks[19], (DEPTH, D_FF, D_MODEL), D_FF ** -0.5),
        'g_final': 1.0 + nrm(ks[20], (D_MODEL,), 0.02),
    }


def reference(x_prompt, x_sample, cache_conv, state_ret, c_prompt, c_sample, w_ada, b_ada, g_mix,
              w_in, conv_w, conv_b, conv_ln_g, conv_ln_b, ret_ln_g, ret_ln_b, w_out, g_ffn,
              w_ff1, w_ff2, g_final):
    hp, hs = x_prompt, x_sample
    bp = x_prompt.shape[0]
    conv_p, ret_p, conv_s, ret_s = [], [], [], []
    for l in range(DEPTH):
        params = (w_ada[l], b_ada[l], g_mix[l], w_in[l], conv_w[l], conv_b[l], conv_ln_g[l],
                  conv_ln_b[l], ret_ln_g[l], ret_ln_b[l], w_out[l], g_ffn[l], w_ff1[l], w_ff2[l])
        zero_hist = jnp.zeros((bp, CONV_K - 1, CONV_CH), x_prompt.dtype)
        zero_state = jnp.zeros((bp, RET_HEADS, RET_DK, RET_DV), state_ret.dtype)
        hp, cp, rp = decoder_layer(hp, c_prompt, zero_hist, zero_state, 0, *params)
        hs, cs, rs = decoder_layer(hs, c_sample, cache_conv[l], state_ret[l], PAST_LEN, *params)
        conv_p.append(cp)
        ret_p.append(rp)
        conv_s.append(cs)
        ret_s.append(rs)
    y_prompt = rmsnorm(hp, g_final)
    y_sample = rmsnorm(hs, g_final)
    return (y_prompt, y_sample, jnp.stack(conv_p), jnp.stack(ret_p), jnp.stack(conv_s), jnp.stack(ret_s))
```

```cpp
#include <hip/hip_runtime.h>
#include <hip/hip_cooperative_groups.h>
#include <cstdio>
#include <cstdint>
namespace pg8 {
#define PG8_LAS __attribute__((address_space(3)))
typedef unsigned short bf16_t;
typedef short bf16x8 __attribute__((ext_vector_type(8)));
typedef float f32x4 __attribute__((ext_vector_type(4)));
typedef unsigned u32x4 __attribute__((ext_vector_type(4)));
constexpr int BM = 256, BK = 64, HALF = 128, HTB = HALF * BK * 2  , STAGE_BYTES = 8 * HTB, NXCD = 8, WGM = 8;

__host__ __device__ __forceinline__ int lds_byte(int r, int c) { const int st = (r >> 4) * 2 + (c >> 5), rr = r & 15, cc = c & 31, ob = rr * 64 + cc * 2; return st * 1024 + (ob ^ (((ob >> 9) & 1) << 5)); }
__host__ __device__ __forceinline__ void stage_rc(int b, int& R, int& C) { const int st = b / 1024, sb = b % 1024, swz = sb ^ (((sb >> 9) & 1) << 5); R = (st >> 1) * 16 + swz / 64; C = (st & 1) * 32 + (swz % 64) / 2; }
__host__ __device__ __forceinline__ int perm32(int rho) { const int n = rho >> 4, i = rho & 15; return 8 * (i >> 2) + 4 * n + (i & 3); }

struct Unit { int pm, pn; };
struct Gemm { const bf16_t* A; const bf16_t* Bt; int M, N, K; };

struct StaticOrder {
    int nM, nN, nwg, G, c;
    __host__ __device__ void init(int M, int N, int G_, int c_) { nM = M / BM; nN = N / BM; nwg = nM * nN; G = G_; c = c_; }
    __host__ __device__ bool next(int i, Unit& u) const {
        const long L = (long)i * G + c; if (L >= nwg) return false;
        int wgid = (int)L; { const int q = nwg / NXCD, r = nwg % NXCD, xcd = wgid % NXCD, off = wgid / NXCD; wgid = (xcd < r ? xcd * (q + 1) : r * (q + 1) + (xcd - r) * q) + off; }
        const int nig = WGM * nN, gid = wgid / nig, fm = gid * WGM, gsz = (nM - fm) < WGM ? (nM - fm) : WGM;
        u.pm = fm + ((wgid % nig) % gsz); u.pn = (wgid % nig) / gsz; return true;
    }
    __device__ __forceinline__ void a_ready(const Unit&) const {}
    __device__ __forceinline__ void done(const Unit&) const {}
};

__device__ __forceinline__ unsigned cvt_pk_bf16(float lo, float hi) { unsigned r; asm volatile("v_cvt_pk_bf16_f32 %0, %1, %2" : "=v"(r) : "v"(lo), "v"(hi)); return r; }
typedef float f32x2 __attribute__((ext_vector_type(2)));
__device__ __forceinline__ float sigmoid_f(float x) { return __builtin_amdgcn_rcpf(1.0f + __expf(-x)); }
__device__ __forceinline__ int bidx_of_row(int r) { return r < 16384 ? (r >> 11) : 8 + ((r - 16384) >> 2); }
__device__ __forceinline__ int posidx_of_row(int r) { return r < 16384 ? (r & 2047) : 2048 + ((r - 16384) & 3); }

struct EpiIn {
    static constexpr bool PERM = true, AFTER_DRAIN = false;
    bf16_t *U, *Q, *Kb, *V, *G; const float* cosT; const float* sinT;
    __device__ __forceinline__ void operator()(const f32x4 (&acc)[2][2][4][2], const Unit& u, int wr, int wc, int fr, int fq) const {
        const int row0 = u.pm * BM + wr * 64 + fr; const int o0 = wc * 32 + 8 * fq; const int pn = u.pn;
        if (pn < 4) {
#pragma unroll
            for (int ai = 0; ai < 2; ++ai)
#pragma unroll
                for (int m = 0; m < 4; ++m) { const int r = row0 + ai * HALF + m * 16;
                    const f32x4 a0 = acc[ai][0][m][0], a1 = acc[ai][0][m][1], b0 = acc[ai][1][m][0], b1 = acc[ai][1][m][1];
                    u32x4 w; w.x = cvt_pk_bf16(a0[0] * sigmoid_f(b0[0]), a0[1] * sigmoid_f(b0[1])); w.y = cvt_pk_bf16(a0[2] * sigmoid_f(b0[2]), a0[3] * sigmoid_f(b0[3]));
                    w.z = cvt_pk_bf16(a1[0] * sigmoid_f(b1[0]), a1[1] * sigmoid_f(b1[1])); w.w = cvt_pk_bf16(a1[2] * sigmoid_f(b1[2]), a1[3] * sigmoid_f(b1[3]));
                    *(u32x4*)(U + (size_t)r * 512 + 128 * pn + o0) = w; }
        } else if (pn < 8) {
            const bool isq = pn < 6; bf16_t* base = isq ? Q : Kb; const float sc = isq ? 0.125f : 1.0f;
            const int colb = (4 * ((pn - 4) & 1) + wc) * 64 + 8 * fq;
#pragma unroll
            for (int ai = 0; ai < 2; ++ai)
#pragma unroll
                for (int m = 0; m < 4; ++m) { const int r = row0 + ai * HALF + m * 16; const int pi = posidx_of_row(r);
                    const f32x4 c0 = *(const f32x4*)(cosT + pi * 32 + 8 * fq), c1 = *(const f32x4*)(cosT + pi * 32 + 8 * fq + 4);
                    const f32x4 s0 = *(const f32x4*)(sinT + pi * 32 + 8 * fq), s1 = *(const f32x4*)(sinT + pi * 32 + 8 * fq + 4);
                    const f32x4 x10 = acc[ai][0][m][0], x11 = acc[ai][0][m][1], x20 = acc[ai][1][m][0], x21 = acc[ai][1][m][1];
                    const f32x4 p0 = (x10 * c0 - x20 * s0) * sc, p1 = (x11 * c1 - x21 * s1) * sc, q0 = (x10 * s0 + x20 * c0) * sc, q1 = (x11 * s1 + x21 * c1) * sc;
                    u32x4 w; w.x = cvt_pk_bf16(p0[0], p0[1]); w.y = cvt_pk_bf16(p0[2], p0[3]); w.z = cvt_pk_bf16(p1[0], p1[1]); w.w = cvt_pk_bf16(p1[2], p1[3]);
                    *(u32x4*)(base + (size_t)r * 512 + colb) = w;
                    w.x = cvt_pk_bf16(q0[0], q0[1]); w.y = cvt_pk_bf16(q0[2], q0[3]); w.z = cvt_pk_bf16(q1[0], q1[1]); w.w = cvt_pk_bf16(q1[2], q1[3]);
                    *(u32x4*)(base + (size_t)r * 512 + colb + 32) = w; }
        } else {
            const bool isg = pn >= 10; bf16_t* base = isg ? G : V; const int colb = 256 * ((pn - 8) & 1) + o0;
#pragma unroll
            for (int ai = 0; ai < 2; ++ai)
#pragma unroll
                for (int m = 0; m < 4; ++m) { const int r = row0 + ai * HALF + m * 16;
#pragma unroll
                    for (int bj = 0; bj < 2; ++bj) { f32x4 v0 = acc[ai][bj][m][0], v1 = acc[ai][bj][m][1];
                        if (isg) {
#pragma unroll
                            for (int e = 0; e < 4; ++e) { v0[e] = v0[e] * sigmoid_f(v0[e]); v1[e] = v1[e] * sigmoid_f(v1[e]); } }
                        u32x4 w; w.x = cvt_pk_bf16(v0[0], v0[1]); w.y = cvt_pk_bf16(v0[2], v0[3]); w.z = cvt_pk_bf16(v1[0], v1[1]); w.w = cvt_pk_bf16(v1[2], v1[3]);
                        *(u32x4*)(base + (size_t)r * 512 + colb + bj * HALF) = w; } }
        }
    }
};

struct EpiRes {
    static constexpr bool PERM = false, AFTER_DRAIN = false;
    const float* xp; const float* xs; float* out; const float* gate;
    __device__ __forceinline__ void operator()(const f32x4 (&acc)[2][2][4][2], const Unit& u, int wr, int wc, int fr, int fq) const {
        const int col0 = u.pn * BM + wc * 32 + 4 * fq;
#pragma unroll
        for (int ai = 0; ai < 2; ++ai)
#pragma unroll
            for (int m = 0; m < 4; ++m) { const int r = u.pm * BM + ai * HALF + wr * 64 + m * 16 + fr;
                const float* xr = r < 16384 ? xp + (size_t)r * 1024 : xs + (size_t)(r - 16384) * 1024; const float* gr = gate + (size_t)bidx_of_row(r) * 6144;
#pragma unroll
                for (int bj = 0; bj < 2; ++bj)
#pragma unroll
                    for (int n = 0; n < 2; ++n) { const int c = col0 + bj * HALF + n * 16;
                        const f32x4 xv = *(const f32x4*)(xr + c), gv = *(const f32x4*)(gr + c);
                        *(f32x4*)(out + (size_t)r * 1024 + c) = xv + gv * acc[ai][bj][m][n]; } }
    }
};

struct EpiFF1 {
    static constexpr bool PERM = true, AFTER_DRAIN = false;
    bf16_t* H;
    __device__ __forceinline__ void operator()(const f32x4 (&acc)[2][2][4][2], const Unit& u, int wr, int wc, int fr, int fq) const {
        const int row0 = u.pm * BM + wr * 64 + fr; const int col0 = u.pn * BM + wc * 32 + 8 * fq;
#pragma unroll
        for (int ai = 0; ai < 2; ++ai)
#pragma unroll
            for (int m = 0; m < 4; ++m) { bf16_t* rowp = H + (size_t)(row0 + ai * HALF + m * 16) * 4096 + col0;
#pragma unroll
                for (int bj = 0; bj < 2; ++bj) { f32x4 v0 = acc[ai][bj][m][0], v1 = acc[ai][bj][m][1];
#pragma unroll
                    for (int e = 0; e < 4; ++e) { const float a = fmaxf(v0[e], 0.f), b = fmaxf(v1[e], 0.f); v0[e] = a * a; v1[e] = b * b; }
                    u32x4 w; w.x = cvt_pk_bf16(v0[0], v0[1]); w.y = cvt_pk_bf16(v0[2], v0[3]); w.z = cvt_pk_bf16(v1[0], v1[1]); w.w = cvt_pk_bf16(v1[2], v1[3]);
                    *(u32x4*)(rowp + bj * HALF) = w; } }
    }
};

template <class Epi, class Sched, bool ALIGN_EPI = false, bool SP2 = false>
__device__ __forceinline__ void gemm_phase(PG8_LAS unsigned char* lds, const Gemm g, const Sched& S, const Epi& E) {
    const int tid = threadIdx.x, wid = __builtin_amdgcn_readfirstlane(tid >> 6), lane = tid & 63, wr = wid >> 2, wc = wid & 3, fr = lane & 15, fq = lane >> 4;
    const int K = g.K, nt = K / BK;
    unsigned voffA[2], voffB[2];
#pragma unroll
    for (int i = 0; i < 2; ++i) { int R, C; stage_rc(tid * 16 + i * 8192, R, C); const int Rb = Epi::PERM ? ((R & ~31) + perm32(R & 31)) : R;
        voffA[i] = (unsigned)(R * K + C) * 2u; voffB[i] = (unsigned)(Rb * K + C) * 2u; }
    const size_t kstep = (size_t)(BK * 2);
    const size_t hstep = (size_t)HALF * K * 2;
    const size_t tstep = 2 * hstep;
    const unsigned ldsw = (unsigned)wid * 1024u;
    const int aoff = lds_byte(wr * 64 + fr, fq * 8), boff = lds_byte(wc * 32 + fr, fq * 8);
#define PG8_SA(b, h) (((b) * 2 + (h)) * HTB)
#define PG8_SB(b, h) ((4 + (b) * 2 + (h)) * HTB)
#define PG8_STAGE(bufoff, gbase, voff) do { _Pragma("unroll") for (int _i = 0; _i < 2; ++_i) \
        __builtin_amdgcn_global_load_lds((const unsigned*)((const char*)(gbase) + (voff)[_i]), (PG8_LAS unsigned*)(lds + (bufoff) + ldsw + _i * 8192), 16, 0, 0); } while (0)
#define PG8_LDA(dst, b, h) do { _Pragma("unroll") for (int m = 0; m < 4; ++m) _Pragma("unroll") for (int k = 0; k < 2; ++k) dst[m][k] = *(const PG8_LAS bf16x8*)(lds + PG8_SA(b, h) + aoff + m * 2048 + k * 1024); } while (0)
#define PG8_LDB(dst, b, h) do { _Pragma("unroll") for (int n = 0; n < 2; ++n) _Pragma("unroll") for (int k = 0; k < 2; ++k) dst[n][k] = *(const PG8_LAS bf16x8*)(lds + PG8_SB(b, h) + boff + n * 2048 + k * 1024); } while (0)
#define PG8_MMA(ai, bj, At, Bt) do { __builtin_amdgcn_s_setprio(1); _Pragma("unroll") for (int m = 0; m < 4; ++m) _Pragma("unroll") for (int n = 0; n < 2; ++n) _Pragma("unroll") for (int k = 0; k < 2; ++k) \
        acc[ai][bj][m][n] = __builtin_amdgcn_mfma_f32_16x16x32_bf16(Bt[n][k], At[m][k], acc[ai][bj][m][n], 0, 0, 0); __builtin_amdgcn_s_setprio(0); } while (0)
#define PG8_WAIT_V(n) asm volatile("s_waitcnt vmcnt(" #n ")" ::: "memory")
#define PG8_WAIT_L(n) asm volatile("s_waitcnt lgkmcnt(" #n ")" ::: "memory")
#define PG8_BAR __builtin_amdgcn_s_barrier()
#define PG8_SCHED __builtin_amdgcn_sched_barrier(0)
    Unit cur, nxt; int ui = 0;
    if (!S.next(0, cur)) return;
    f32x4 acc[2][2][4][2];
#pragma unroll
    for (int a = 0; a < 2; ++a)
#pragma unroll
        for (int b = 0; b < 2; ++b)
#pragma unroll
            for (int m = 0; m < 4; ++m)
#pragma unroll
                for (int n = 0; n < 2; ++n) acc[a][b][m][n] = (f32x4){0.f, 0.f, 0.f, 0.f};
    bf16x8 At[4][2], B0[2][2], B1[2][2];
    const char* cA = (const char*)g.A + (size_t)cur.pm * tstep; const char* cB = (const char*)g.Bt + (size_t)cur.pn * tstep;
    S.a_ready(cur);
    if constexpr (SP2) {
        PG8_STAGE(PG8_SB(0, 0), cB, voffB); PG8_STAGE(PG8_SB(0, 1), cB + hstep, voffB); PG8_STAGE(PG8_SA(0, 0), cA, voffA); PG8_STAGE(PG8_SA(0, 1), cA + hstep, voffA);
        if (wr == 1) PG8_BAR;
        PG8_WAIT_V(2); PG8_BAR;
        PG8_STAGE(PG8_SB(1, 0), cB + kstep, voffB); PG8_STAGE(PG8_SA(1, 0), cA + kstep, voffA); PG8_STAGE(PG8_SB(1, 1), cB + hstep + kstep, voffB);
        PG8_WAIT_V(6); PG8_BAR;
    } else {
        PG8_STAGE(PG8_SB(0, 0), cB, voffB); PG8_STAGE(PG8_SA(0, 0), cA, voffA); PG8_STAGE(PG8_SB(0, 1), cB + hstep, voffB); PG8_STAGE(PG8_SA(0, 1), cA + hstep, voffA);
        if (wr == 1) PG8_BAR;
        PG8_WAIT_V(4); PG8_BAR;
        PG8_STAGE(PG8_SB(1, 0), cB + kstep, voffB); PG8_STAGE(PG8_SA(1, 0), cA + kstep, voffA); PG8_STAGE(PG8_SB(1, 1), cB + hstep + kstep, voffB);
        PG8_WAIT_V(6); PG8_BAR;
    }
    for (;;) {
        const bool has_next = S.next(ui + 1, nxt);
        const char* nA = has_next ? (const char*)g.A + (size_t)nxt.pm * tstep : cA; const char* nB = has_next ? (const char*)g.Bt + (size_t)nxt.pn * tstep : cB;
        for (int t = 0; t < nt; t += 2) {
            const bool last = (t == nt - 2);
            const char* a1 = cA + (size_t)(t + 1) * kstep;
            const char* a2 = last ? nA : cA + (size_t)(t + 2) * kstep; const char* b2 = last ? nB : cB + (size_t)(t + 2) * kstep;
            const char* a3 = a2 + kstep; const char* b3 = b2 + kstep;
            if (last && has_next) S.a_ready(nxt);
            if constexpr (SP2) {
            PG8_LDB(B0, 0, 0); PG8_LDB(B1, 0, 1); PG8_SCHED; PG8_LDA(At, 0, 0); PG8_STAGE(PG8_SA(1, 1), a1 + hstep, voffA);
            PG8_WAIT_V(8); PG8_WAIT_L(0); PG8_BAR; PG8_MMA(0, 0, At, B0); PG8_MMA(0, 1, At, B1); PG8_BAR; PG8_SCHED;
            PG8_LDA(At, 0, 1); PG8_STAGE(PG8_SB(0, 0), b2, voffB); PG8_STAGE(PG8_SB(0, 1), b2 + hstep, voffB); PG8_STAGE(PG8_SA(0, 0), a2, voffA);
            PG8_WAIT_V(8); PG8_WAIT_L(0); PG8_BAR; PG8_MMA(1, 0, At, B0); PG8_MMA(1, 1, At, B1); PG8_BAR; PG8_SCHED;
            PG8_LDB(B0, 1, 0); PG8_LDB(B1, 1, 1); PG8_SCHED; PG8_LDA(At, 1, 0); PG8_STAGE(PG8_SA(0, 1), a2 + hstep, voffA);
            PG8_WAIT_V(8); PG8_WAIT_L(0); PG8_BAR; PG8_MMA(0, 0, At, B0); PG8_MMA(0, 1, At, B1); PG8_BAR; PG8_SCHED;
            PG8_LDA(At, 1, 1); PG8_STAGE(PG8_SB(1, 0), b3, voffB); PG8_STAGE(PG8_SB(1, 1), b3 + hstep, voffB); PG8_STAGE(PG8_SA(1, 0), a3, voffA);
            PG8_WAIT_V(8); PG8_WAIT_L(0); PG8_BAR; PG8_MMA(1, 0, At, B0); PG8_MMA(1, 1, At, B1); PG8_BAR; PG8_SCHED;
            } else {
            PG8_LDB(B0, 0, 0); PG8_SCHED; PG8_LDA(At, 0, 0); PG8_STAGE(PG8_SA(1, 1), a1 + hstep, voffA);
            PG8_WAIT_L(8); PG8_BAR; PG8_WAIT_L(0); PG8_MMA(0, 0, At, B0); PG8_BAR; PG8_SCHED;
            PG8_LDB(B1, 0, 1); PG8_STAGE(PG8_SB(0, 0), b2, voffB);
            PG8_BAR; PG8_WAIT_L(0); PG8_MMA(0, 1, At, B1); PG8_BAR;
            PG8_LDA(At, 0, 1); PG8_STAGE(PG8_SA(0, 0), a2, voffA);
            PG8_BAR; PG8_WAIT_L(0); PG8_MMA(1, 0, At, B0); PG8_BAR; PG8_SCHED;
            PG8_STAGE(PG8_SB(0, 1), b2 + hstep, voffB);
            PG8_WAIT_V(6); PG8_BAR; PG8_MMA(1, 1, At, B1); PG8_BAR;
            PG8_LDB(B0, 1, 0); PG8_SCHED; PG8_LDA(At, 1, 0); PG8_STAGE(PG8_SA(0, 1), a2 + hstep, voffA);
            PG8_WAIT_L(8); PG8_BAR; PG8_WAIT_L(0); PG8_MMA(0, 0, At, B0); PG8_BAR; PG8_SCHED;
            PG8_LDB(B1, 1, 1); PG8_STAGE(PG8_SB(1, 0), b3, voffB);
            PG8_BAR; PG8_WAIT_L(0); PG8_MMA(0, 1, At, B1); PG8_BAR;
            PG8_LDA(At, 1, 1); PG8_STAGE(PG8_SA(1, 0), a3, voffA);
            PG8_BAR; PG8_WAIT_L(0); PG8_MMA(1, 0, At, B0); PG8_BAR; PG8_SCHED;
            PG8_STAGE(PG8_SB(1, 1), b3 + hstep, voffB);
            PG8_WAIT_V(6); PG8_BAR; PG8_MMA(1, 1, At, B1); PG8_BAR;
            }
        }
        if constexpr (ALIGN_EPI) { if (wr == 0) PG8_BAR; }
        if constexpr (!Epi::AFTER_DRAIN) { E(acc, cur, wr, wc, fr, fq); S.done(cur); }
        if (!has_next) break;
#pragma unroll
        for (int a = 0; a < 2; ++a)
#pragma unroll
            for (int b = 0; b < 2; ++b)
#pragma unroll
                for (int m = 0; m < 4; ++m)
#pragma unroll
                    for (int n = 0; n < 2; ++n) acc[a][b][m][n] = (f32x4){0.f, 0.f, 0.f, 0.f};
        cur = nxt; cA = nA; cB = nB; ++ui;
        if constexpr (ALIGN_EPI) { if (wr == 1) PG8_BAR; }
    }
    PG8_WAIT_V(0);
    if constexpr (!ALIGN_EPI) { if (wr == 0) PG8_BAR; }
    PG8_BAR;
    if constexpr (Epi::AFTER_DRAIN) { E.fused(acc, cur, wr, wc, fr, fq, lds, wid, lane); S.done(cur); }
#undef PG8_SA
#undef PG8_SB
#undef PG8_STAGE
#undef PG8_LDA
#undef PG8_LDB
#undef PG8_MMA
#undef PG8_WAIT_V
#undef PG8_WAIT_L
#undef PG8_BAR
#undef PG8_SCHED
}
}
namespace cg = cooperative_groups;
#define LAS __attribute__((address_space(3)))
#define DI __device__ __forceinline__
typedef unsigned short bf16;
typedef float f32x4 __attribute__((ext_vector_type(4)));
typedef float f32x16 __attribute__((ext_vector_type(16)));
typedef short bf16x8 __attribute__((ext_vector_type(8)));
typedef unsigned u32x4 __attribute__((ext_vector_type(4)));
typedef unsigned u32x2 __attribute__((ext_vector_type(2)));

#ifndef MK_ONE_LAUNCH
#define MK_ONE_LAUNCH 1
#endif
constexpr int NPHASE = 10;
constexpr int D = 1024, MP = 16384, MS = 512, M = MP + MS, DIN = 3072, FF = 4096, NB = 136, NMOD = 6144;
constexpr float EPS = 1e-6f;
constexpr size_t MiB = 1u << 20;
constexpr size_t SZ512 = (size_t)M * 512 * 2;
constexpr size_t WS_WIN = 1 * MiB, WS_WOUT = 7 * MiB, WS_W1 = 9 * MiB, WS_W2 = 17 * MiB, WS_MOD = 25 * MiB, WS_COS = 29 * MiB, WS_SIN = 29 * MiB + 512 * 1024, WS_XN = 30 * MiB;
constexpr size_t WS_U = 63 * MiB, WS_Q = WS_U + SZ512, WS_K = WS_Q + SZ512, WS_V = WS_K + SZ512, WS_G = WS_V + SZ512, WS_MIX = WS_G + SZ512, WS_L = WS_MIX + (size_t)M * 1024 * 2, WS_H = 63 * MiB;
constexpr size_t WS_END = WS_L + 16 * MiB;
static_assert(WS_XN + (size_t)M * D * 2 <= WS_U && WS_H + (size_t)M * FF * 2 <= 256 * MiB && WS_END <= 256 * MiB, "d_ws map");
constexpr size_t OUT_Y = 0, OUT_CONVP = (size_t)M * D, OUT_RETP = OUT_CONVP + 8 * 30 * 512, OUT_CONVS = OUT_RETP + 8 * 8 * 4096, OUT_RETS = OUT_CONVS + 128 * 30 * 512, OUT_END = OUT_RETS + (size_t)128 * 8 * 4096;
constexpr int LDS_BYTES = 147456;

__device__ const double INV_FREQ[32] = {1.0, 0.7498942093324559, 0.5623413251903491, 0.4216965034285822, 0.31622776601683794, 0.23713737056616552, 0.1778279410038923, 0.1333521432163324, 0.1, 0.07498942093324558, 0.05623413251903491, 0.042169650342858224, 0.03162277660168379, 0.023713737056616554, 0.01778279410038923, 0.01333521432163324, 0.01, 0.007498942093324558, 0.005623413251903491, 0.004216965034285823, 0.0031622776601683794, 0.0023713737056616554, 0.0017782794100389228, 0.001333521432163324, 0.001, 0.0007498942093324559, 0.0005623413251903491, 0.00042169650342858224, 0.00031622776601683794, 0.00023713737056616554, 0.00017782794100389227, 0.0001333521432163324};
__device__ const float LOG2G[8] = {-0.04580368961312479f, -0.02272007650008353f, -0.011315313227834146f, -0.005646563141142063f, -0.0028205190623786626f, -0.0014095702546713536f, -0.0007046129765893727f, -0.0003522634716290214f};

#define LDS_WAIT() asm volatile("s_waitcnt lgkmcnt(0)" ::: "memory")
DI unsigned f2bf(float f) { unsigned u = __builtin_bit_cast(unsigned, f); return (u + 0x7fffu + ((u >> 16) & 1u)) >> 16; }
DI unsigned pk2(float lo, float hi) { return f2bf(lo) | (f2bf(hi) << 16); }
DI float bf2f(unsigned h) { return __builtin_bit_cast(float, h << 16); }
DI float bflo(unsigned w) { return __builtin_bit_cast(float, w << 16); }
DI float bfhi(unsigned w) { return __builtin_bit_cast(float, w & 0xffff0000u); }
DI float sigm(float x) { return __builtin_amdgcn_rcpf(1.0f + __expf(-x)); }
DI float ex2(float x) { return __builtin_amdgcn_exp2f(x); }
DI float wave_sum(float v) {
#pragma unroll
    for (int o = 1; o < 64; o <<= 1) v += __shfl_xor(v, o);
    return v;
}
DI float sum16(float v) { v += __shfl_xor(v, 1); v += __shfl_xor(v, 2); v += __shfl_xor(v, 4); v += __shfl_xor(v, 8); return v; }

struct Args { const float* in[21]; float* out; unsigned char* ws; int ph_lo, ph_hi; };
struct Ctx {
    LAS unsigned char* lds; int tid, lane, wave, G, bid;
    const float *xp, *xs, *cache, *state, *cp, *cs, *w_ada, *b_ada, *g_mix, *w_in, *conv_w, *conv_b, *cln_g, *cln_b, *rln_g, *rln_b, *w_out, *g_ffn, *w_ff1, *w_ff2, *g_fin;
    float* out; bf16 *Wt_in, *Wt_out, *Wt_1, *Wt_2, *XN, *U, *Q, *K, *V, *Gt, *MIX, *H; float *MOD, *cosT, *sinT, *L;
};

DI f32x4 tile16(const LAS bf16* A, int lda, const LAS bf16* Bt, int ldb, int m0, int n0, int K, int lane) {
    const int r = lane & 15, q = lane >> 4; f32x4 acc = {0.f, 0.f, 0.f, 0.f};
    const LAS bf16* ap = A + (m0 + r) * lda + q * 8; const LAS bf16* bp = Bt + (n0 + r) * ldb + q * 8;
    for (int k = 0; k < K; k += 32) { const bf16x8 a = *(const LAS bf16x8*)(ap + k); const bf16x8 b = *(const LAS bf16x8*)(bp + k); acc = __builtin_amdgcn_mfma_f32_16x16x32_bf16(a, b, acc, 0, 0, 0); }
    return acc;
}

DI int win_dest_row(int c0) {
    if (c0 < 512) return 256 * (c0 >> 7) + (c0 & 127);
    if (c0 < 1024) { const int c = c0 - 512; return 256 * (c >> 7) + 128 + (c & 127); }
    if (c0 < 2048) { const int grp = (c0 - 1024) >> 9, c = (c0 - 1024) & 511, head = c >> 6, half = (c >> 5) & 1; return 256 * (4 + 2 * grp + (head >> 2)) + 128 * half + 32 * (head & 3); }
    return c0;
}
DI void p0_transpose_item(const float* W, int K, int N, bf16* WT, bool win, LAS float* scr, int item, int lane) {
    const int nblk = N / 32, kb = item / nblk, nb = item % nblk, k0 = 64 * kb, n0 = 32 * nb;
    const int drow = win ? win_dest_row(n0) : n0;
#pragma unroll 8
    for (int i = 0; i < 32; ++i) { const int kk = 2 * i + (lane >> 5); scr[kk * 33 + (lane & 31)] = W[(size_t)(k0 + kk) * N + n0 + (lane & 31)]; }
    LDS_WAIT();
    const int c = lane & 7;
#pragma unroll
    for (int j = 0; j < 4; ++j) { const int n = (lane >> 3) + 8 * j; const LAS float* s = scr + (8 * c) * 33 + n;
        u32x4 o; o.x = pk2(s[0 * 33], s[1 * 33]); o.y = pk2(s[2 * 33], s[3 * 33]); o.z = pk2(s[4 * 33], s[5 * 33]); o.w = pk2(s[6 * 33], s[7 * 33]);
        *(u32x4*)(WT + (size_t)(drow + n) * K + k0 + 8 * c) = o; }
    LDS_WAIT();
}
DI void p0_mod(const Ctx& F) {
    for (int cb = F.bid; cb < 192; cb += F.G) {
    const int n0 = 32 * cb; LAS float* OUT = (LAS float*)F.lds;
    const int r32 = F.lane & 31, hi = F.lane >> 5, k0 = F.wave * 128;
    f32x16 acc[5];
#pragma unroll
    for (int mt = 0; mt < 5; ++mt)
#pragma unroll
        for (int i = 0; i < 16; ++i) acc[mt][i] = 0.f;
    for (int ks = 0; ks < 8; ++ks) {
        const int kb = k0 + ks * 16 + 8 * hi;
        bf16x8 b;
#pragma unroll
        for (int j = 0; j < 8; ++j) b[j] = (short)f2bf(F.w_ada[(size_t)(kb + j) * NMOD + n0 + r32]);
#pragma unroll
        for (int mt = 0; mt < 5; ++mt) { const int r = mt * 32 + r32; bf16x8 a = {0, 0, 0, 0, 0, 0, 0, 0};
            if (r < NB) { const float* cr = r < 8 ? F.cp + (size_t)r * D : F.cs + (size_t)(r - 8) * D; const f32x4 x0 = *(const f32x4*)(cr + kb), x1 = *(const f32x4*)(cr + kb + 4);
#pragma unroll
                for (int j = 0; j < 4; ++j) { a[j] = (short)f2bf(x0[j] * sigm(x0[j])); a[4 + j] = (short)f2bf(x1[j] * sigm(x1[j])); } }
            acc[mt] = __builtin_amdgcn_mfma_f32_32x32x16_bf16(a, b, acc[mt], 0, 0, 0); }
    }
    for (int w = 0; w < 8; ++w) {
        if (F.wave == w) {
#pragma unroll
            for (int mt = 0; mt < 5; ++mt)
#pragma unroll
                for (int i = 0; i < 16; ++i) { const int row = mt * 32 + (i & 3) + 8 * (i >> 2) + 4 * hi; const float prev = (w == 0) ? 0.f : OUT[row * 32 + r32]; OUT[row * 32 + r32] = prev + acc[mt][i]; }
        }
        __syncthreads();
    }
    for (int i = F.tid; i < NB * 32; i += 512) { const int r = i >> 5, c = i & 31; F.MOD[(size_t)r * NMOD + n0 + c] = OUT[i] + F.b_ada[n0 + c]; }
    __syncthreads();
    }
}
DI void p0_prologue(const Ctx& F) {
    p0_mod(F);
    for (int i = F.bid * 512 + F.tid; i < 2052 * 32; i += F.G * 512) { const int p = i >> 5, d = i & 31; const double pos = p < 2048 ? (double)p : (double)(16384 + (p - 2048));
        double rev = pos * INV_FREQ[d] * 0.15915494309189535; rev -= floor(rev); const float fr = (float)rev; F.cosT[i] = __builtin_amdgcn_cosf(fr); F.sinT[i] = __builtin_amdgcn_sinf(fr); }
    LAS float* scr = (LAS float*)(F.lds + F.wave * 16384);
    const int gw = F.bid * 8 + F.wave, NGW = F.G * 8;
    constexpr int I_IN = (D / 64) * (DIN / 32), I_O = (D / 64) * (D / 32), I_1 = (D / 64) * (FF / 32), I_2 = (FF / 64) * (D / 32), NITEMS = I_IN + I_O + I_1 + I_2;
    for (int it = gw; it < NITEMS; it += NGW) { int r = it;
        if (r < I_IN) { p0_transpose_item(F.w_in, D, DIN, F.Wt_in, true, scr, r, F.lane); continue; } r -= I_IN;
        if (r < I_O) { p0_transpose_item(F.w_out, D, D, F.Wt_out, false, scr, r, F.lane); continue; } r -= I_O;
        if (r < I_1) { p0_transpose_item(F.w_ff1, D, FF, F.Wt_1, false, scr, r, F.lane); continue; } r -= I_1;
        p0_transpose_item(F.w_ff2, FF, D, F.Wt_2, false, scr, r, F.lane); }
}

DI void modnorm_phase(const Ctx& F, const float* x0, const float* x1, const float* g, int sh_off, int sc_off) {
    const int gw = F.bid * 8 + F.wave, NGW = F.G * 8;
    for (int m = gw; m < M; m += NGW) {
        const float* xrow = m < MP ? x0 + (size_t)m * D : x1 + (size_t)(m - MP) * D; const float* mod = F.MOD + (size_t)pg8::bidx_of_row(m) * NMOD;
        const f32x4* xr = (const f32x4*)xrow + F.lane; f32x4 v[4]; float s = 0.f;
#pragma unroll
        for (int j = 0; j < 4; ++j) { v[j] = xr[64 * j]; s += (v[j].x * v[j].x + v[j].y * v[j].y) + (v[j].z * v[j].z + v[j].w * v[j].w); }
        const float rstd = 1.0f / sqrtf(wave_sum(s) * (1.f / D) + EPS);
        u32x2* o8 = (u32x2*)(F.XN + (size_t)m * D) + F.lane;
#pragma unroll
        for (int j = 0; j < 4; ++j) { const f32x4 gv = ((const f32x4*)g)[F.lane + 64 * j], sh = ((const f32x4*)(mod + sh_off))[F.lane + 64 * j], sc = ((const f32x4*)(mod + sc_off))[F.lane + 64 * j];
            const f32x4 y = v[j] * rstd * gv * (sc + 1.0f) + sh; u32x2 w; w.x = pk2(y.x, y.y); w.y = pk2(y.z, y.w); o8[64 * j] = w; }
    }
}
DI void final_norm_phase(const Ctx& F) {
    const int gw = F.bid * 8 + F.wave, NGW = F.G * 8;
    for (int m = gw; m < M; m += NGW) {
        f32x4* xr = (f32x4*)(F.out + (size_t)m * D) + F.lane; f32x4 v[4]; float s = 0.f;
#pragma unroll
        for (int j = 0; j < 4; ++j) { v[j] = xr[64 * j]; s += (v[j].x * v[j].x + v[j].y * v[j].y) + (v[j].z * v[j].z + v[j].w * v[j].w); }
        const float rstd = 1.0f / sqrtf(wave_sum(s) * (1.f / D) + EPS);
#pragma unroll
        for (int j = 0; j < 4; ++j) xr[64 * j] = v[j] * rstd * ((const f32x4*)F.g_fin)[F.lane + 64 * j];
    }
}

DI void ret_local_unit(const Ctx& F, int uid) {
    const int b = uid >> 7, h = (uid >> 4) & 7, n = uid & 15, row0 = b * 2048 + n * 128; const float lg = LOG2G[h];
    LAS bf16* KT = (LAS bf16*)F.lds; LAS bf16* VT = (LAS bf16*)(F.lds + 17408);
    { const int j = F.tid >> 2, d0 = (F.tid & 3) * 16; const float f = ex2(lg * (float)(127 - j));
      const u32x4* kp = (const u32x4*)(F.K + (size_t)(row0 + j) * 512 + h * 64 + d0); const u32x4* vp = (const u32x4*)(F.V + (size_t)(row0 + j) * 512 + h * 64 + d0);
      const u32x4 k0 = kp[0], k1 = kp[1], v0 = vp[0], v1 = vp[1];
#pragma unroll
      for (int e = 0; e < 4; ++e) {
          KT[(d0 + 2 * e) * 136 + j] = (bf16)f2bf(bflo(k0[e]) * f); KT[(d0 + 2 * e + 1) * 136 + j] = (bf16)f2bf(bfhi(k0[e]) * f);
          KT[(d0 + 8 + 2 * e) * 136 + j] = (bf16)f2bf(bflo(k1[e]) * f); KT[(d0 + 8 + 2 * e + 1) * 136 + j] = (bf16)f2bf(bfhi(k1[e]) * f);
          VT[(d0 + 2 * e) * 136 + j] = (bf16)(v0[e] & 0xffffu); VT[(d0 + 2 * e + 1) * 136 + j] = (bf16)(v0[e] >> 16);
          VT[(d0 + 8 + 2 * e) * 136 + j] = (bf16)(v1[e] & 0xffffu); VT[(d0 + 8 + 2 * e + 1) * 136 + j] = (bf16)(v1[e] >> 16); } }
    __syncthreads();
    const int r = F.lane & 15, q = F.lane >> 4;
#pragma unroll
    for (int t2 = 0; t2 < 2; ++t2) { const int t = 2 * F.wave + t2, m0 = (t >> 2) * 16, n0 = (t & 3) * 16; const f32x4 acc = tile16(KT, 136, VT, 136, m0, n0, 128, F.lane);
#pragma unroll
        for (int i = 0; i < 4; ++i) F.L[(size_t)uid * 4096 + (m0 + 4 * q + i) * 64 + n0 + r] = acc[i]; }
    __syncthreads();
}
DI void conv_ln_store(const Ctx& F, const LAS float* dwrow, bf16* dst) {
    const f32x4 a = *(const LAS f32x4*)(dwrow + F.lane * 8), b = *(const LAS f32x4*)(dwrow + F.lane * 8 + 4);
    const float mean = wave_sum((a.x + a.y) + (a.z + a.w) + (b.x + b.y) + (b.z + b.w)) * (1.f / 512);
    const f32x4 da = a - mean, db = b - mean;
    const float var = wave_sum((da.x * da.x + da.y * da.y) + (da.z * da.z + da.w * da.w) + (db.x * db.x + db.y * db.y) + (db.z * db.z + db.w * db.w)) * (1.f / 512);
    const float rstd = 1.0f / sqrtf(var + EPS);
    const f32x4 g0 = *(const f32x4*)(F.cln_g + F.lane * 8), g1 = *(const f32x4*)(F.cln_g + F.lane * 8 + 4), b0 = *(const f32x4*)(F.cln_b + F.lane * 8), b1 = *(const f32x4*)(F.cln_b + F.lane * 8 + 4);
    f32x4 y0 = da * rstd * g0 + b0, y1 = db * rstd * g1 + b1;
#pragma unroll
    for (int e = 0; e < 4; ++e) { y0[e] = y0[e] * sigm(y0[e]); y1[e] = y1[e] * sigm(y1[e]); }
    u32x4 w; w.x = pk2(y0[0], y0[1]); w.y = pk2(y0[2], y0[3]); w.z = pk2(y1[0], y1[1]); w.w = pk2(y1[2], y1[3]);
    *(u32x4*)(dst + F.lane * 8) = w;
}
DI void conv_prompt_unit(const Ctx& F, int cid, const float (&w)[31], float bias) {
    const int b = cid >> 6, t0 = (cid & 63) * 32, ch = F.tid;
    LAS bf16* Us = (LAS bf16*)F.lds; LAS float* DW = (LAS float*)(F.lds + 63488);
    for (int c = F.tid; c < 62 * 64; c += 512) { const int row = c >> 6, cc = c & 63, t = t0 - 30 + row; u32x4 v = {0u, 0u, 0u, 0u};
        if (t >= 0) v = *(const u32x4*)(F.U + (size_t)(b * 2048 + t) * 512 + cc * 8);
        *(LAS u32x4*)(Us + row * 512 + cc * 8) = v; }
    __syncthreads();
#pragma unroll 1
    for (int tb = 0; tb < 4; ++tb) { float acc[8];
#pragma unroll
        for (int o = 0; o < 8; ++o) acc[o] = bias;
#pragma unroll
        for (int jj = 0; jj < 38; ++jj) { const float x = bf2f(Us[(tb * 8 + jj) * 512 + ch]);
#pragma unroll
            for (int o = 0; o < 8; ++o) { const int j = jj - o; if (j >= 0 && j < 31) acc[o] += w[j] * x; } }
#pragma unroll
        for (int o = 0; o < 8; ++o) DW[(tb * 8 + o) * 512 + ch] = acc[o]; }
    if (t0 == 2016) {
#pragma unroll 1
        for (int i = 0; i < 30; ++i) F.out[OUT_CONVP + (size_t)(b * 30 + i) * 512 + ch] = bf2f(Us[(32 + i) * 512 + ch]); }
    __syncthreads();
#pragma unroll 1
    for (int i = 0; i < 4; ++i) { const int tt = F.wave + 8 * i; conv_ln_store(F, DW + tt * 512, F.MIX + (size_t)(b * 2048 + t0 + tt) * 1024); }
    __syncthreads();
}
DI void conv_sample_unit(const Ctx& F, int bs, const float (&w)[31], float bias) {
    const int ch = F.tid; LAS float* DW = (LAS float*)F.lds;
    float ext[34];
#pragma unroll
    for (int i = 0; i < 30; ++i) ext[i] = F.cache[(size_t)(bs * 30 + i) * 512 + ch];
#pragma unroll
    for (int t = 0; t < 4; ++t) ext[30 + t] = bf2f(F.U[(size_t)(MP + bs * 4 + t) * 512 + ch]);
#pragma unroll
    for (int t = 0; t < 4; ++t) { float a = bias;
#pragma unroll
        for (int j = 0; j < 31; ++j) a += w[j] * ext[t + j];
        DW[t * 512 + ch] = a; }
#pragma unroll
    for (int i = 0; i < 30; ++i) F.out[OUT_CONVS + (size_t)(bs * 30 + i) * 512 + ch] = ext[4 + i];
    __syncthreads();
    if (F.wave < 4) conv_ln_store(F, DW + F.wave * 512, F.MIX + (size_t)(MP + bs * 4 + F.wave) * 1024);
    __syncthreads();
}
DI void ret_sample_unit(const Ctx& F, int unit) {
    const int bs = unit >> 3, h = unit & 7, rowb = MP + bs * 4, lane = F.lane; const float lg = LOG2G[h];
    LAS float* QT = (LAS float*)(F.lds + F.wave * 2048); LAS float* KT = QT + 256;
    float qv[4], kv[4], vv[4];
#pragma unroll
    for (int i = 0; i < 4; ++i) { const size_t o = (size_t)(rowb + i) * 512 + h * 64 + lane; qv[i] = bf2f(F.Q[o]); kv[i] = bf2f(F.K[o]); vv[i] = bf2f(F.V[o]); QT[lane * 4 + i] = qv[i]; KT[lane * 4 + i] = kv[i]; }
    LDS_WAIT();
    const float g1 = ex2(lg), g2 = ex2(2.f * lg), g3 = ex2(3.f * lg), g4 = ex2(4.f * lg);
    const float gp[4] = {1.0f, g1, g2, g3};
    float A[4][4];
#pragma unroll
    for (int i = 0; i < 4; ++i)
#pragma unroll
        for (int j = 0; j < 4; ++j) A[i][j] = (j <= i) ? wave_sum(qv[i] * kv[j]) * gp[i - j] : 0.f;
    float cross[4] = {0.f, 0.f, 0.f, 0.f};
    const float* S0 = F.state + (size_t)(bs * 8 + h) * 4096 + lane; float* S1 = F.out + OUT_RETS + (size_t)(bs * 8 + h) * 4096 + lane;
    const float kv0 = g3 * vv[0], kv1 = g2 * vv[1], kv2 = g1 * vv[2], kv3 = vv[3];
#pragma unroll 8
    for (int d = 0; d < 64; ++d) { const float s = S0[d * 64]; const f32x4 qd = *(const LAS f32x4*)(QT + d * 4), kd = *(const LAS f32x4*)(KT + d * 4);
        cross[0] += qd[0] * s; cross[1] += qd[1] * s; cross[2] += qd[2] * s; cross[3] += qd[3] * s;
        S1[d * 64] = g4 * s + kd[0] * kv0 + kd[1] * kv1 + kd[2] * kv2 + kd[3] * kv3; }
    const float gq[4] = {g1, g2, g3, g4};
    const float lng = F.rln_g[h * 64 + lane], lnb = F.rln_b[h * 64 + lane];
#pragma unroll
    for (int i = 0; i < 4; ++i) { float o = gq[i] * cross[i];
#pragma unroll
        for (int j = 0; j < 4; ++j) if (j <= i) o += A[i][j] * vv[j];
        const float mean = wave_sum(o) * (1.f / 64), dl = o - mean, var = wave_sum(dl * dl) * (1.f / 64);
        float y = dl * (1.0f / sqrtf(var + EPS)) * lng + lnb; y *= bf2f(F.Gt[(size_t)(rowb + i) * 512 + h * 64 + lane]);
        F.MIX[(size_t)(rowb + i) * 1024 + 512 + h * 64 + lane] = (bf16)f2bf(y); }
    LDS_WAIT();
}
DI void p3a_phase(const Ctx& F) {
    for (int u = F.bid; u < 1024; u += F.G) ret_local_unit(F, u);
    float w[31];
#pragma unroll
    for (int j = 0; j < 31; ++j) w[j] = F.conv_w[j * 512 + F.tid];
    const float bias = F.conv_b[F.tid];
    for (int c = F.bid; c < 512; c += F.G) conv_prompt_unit(F, c, w, bias);
    const int nconv_wg = F.G >= 256 ? 128 : F.G / 2;
    if (F.bid < nconv_wg) { for (int bs = F.bid; bs < 128; bs += nconv_wg) conv_sample_unit(F, bs, w, bias); }
    else { const int nw = (F.G - nconv_wg) * 8; for (int un = (F.bid - nconv_wg) * 8 + F.wave; un < 1024; un += nw) ret_sample_unit(F, un); }
}
DI void ret_out_unit(const Ctx& F, int uid) {
    const int b = uid >> 7, h = (uid >> 4) & 7, n = uid & 15, row0 = b * 2048 + n * 128; const float lg = LOG2G[h];
    LAS bf16* Qs = (LAS bf16*)F.lds; LAS bf16* Ks = (LAS bf16*)(F.lds + 18432); LAS bf16* Vt = (LAS bf16*)(F.lds + 36864); LAS bf16* PA = (LAS bf16*)(F.lds + 62464);
    { const int j = F.tid >> 2, d0 = (F.tid & 3) * 16; const float f = ex2(lg * (float)(j + 1));
      const size_t go = (size_t)(row0 + j) * 512 + h * 64 + d0;
      const u32x4 q0 = ((const u32x4*)(F.Q + go))[0], q1 = ((const u32x4*)(F.Q + go))[1], k0 = ((const u32x4*)(F.K + go))[0], k1 = ((const u32x4*)(F.K + go))[1], v0 = ((const u32x4*)(F.V + go))[0], v1 = ((const u32x4*)(F.V + go))[1];
      *(LAS u32x4*)(Qs + j * 72 + d0) = q0; *(LAS u32x4*)(Qs + j * 72 + d0 + 8) = q1; *(LAS u32x4*)(Ks + j * 72 + d0) = k0; *(LAS u32x4*)(Ks + j * 72 + d0 + 8) = k1;
      u32x4 a0, a1;
#pragma unroll
      for (int e = 0; e < 4; ++e) { a0[e] = pk2(bflo(q0[e]) * f, bfhi(q0[e]) * f); a1[e] = pk2(bflo(q1[e]) * f, bfhi(q1[e]) * f); }
      *(LAS u32x4*)(PA + j * 200 + 128 + d0) = a0; *(LAS u32x4*)(PA + j * 200 + 128 + d0 + 8) = a1;
#pragma unroll
      for (int e = 0; e < 4; ++e) {
          Vt[(d0 + 2 * e) * 200 + j] = (bf16)(v0[e] & 0xffffu); Vt[(d0 + 2 * e + 1) * 200 + j] = (bf16)(v0[e] >> 16);
          Vt[(d0 + 8 + 2 * e) * 200 + j] = (bf16)(v1[e] & 0xffffu); Vt[(d0 + 8 + 2 * e + 1) * 200 + j] = (bf16)(v1[e] >> 16); } }
    { const int e0 = F.tid * 8, d = F.tid >> 3, dv0 = (F.tid & 7) * 8; const float gC = ex2(lg * 128.f);
      f32x4 s0 = {0.f, 0.f, 0.f, 0.f}, s1 = {0.f, 0.f, 0.f, 0.f}; const float* Lb = F.L + (size_t)(uid - n) * 4096 + e0;
      for (int m = 0; m < n; ++m) { const f32x4 l0 = *(const f32x4*)(Lb + (size_t)m * 4096), l1 = *(const f32x4*)(Lb + (size_t)m * 4096 + 4); s0 = s0 * gC + l0; s1 = s1 * gC + l1; }
#pragma unroll
      for (int e = 0; e < 4; ++e) { Vt[(dv0 + e) * 200 + 128 + d] = (bf16)f2bf(s0[e]); Vt[(dv0 + 4 + e) * 200 + 128 + d] = (bf16)f2bf(s1[e]); }
      if (n == 15) { const f32x4 l0 = *(const f32x4*)(Lb + (size_t)15 * 4096), l1 = *(const f32x4*)(Lb + (size_t)15 * 4096 + 4);
          float* rp = F.out + OUT_RETP + (size_t)(b * 8 + h) * 4096 + e0; *(f32x4*)rp = s0 * gC + l0; *(f32x4*)(rp + 4) = s1 * gC + l1; } }
    __syncthreads();
    const int r = F.lane & 15, q = F.lane >> 4, w = F.wave;
    for (int jt = 0; jt < 8; ++jt) {
        if (jt <= w) { const f32x4 acc = tile16(Qs, 72, Ks, 72, 16 * w, 16 * jt, 64, F.lane);
#pragma unroll
            for (int i = 0; i < 4; ++i) { const int ii = 16 * w + 4 * q + i, jj = 16 * jt + r; const float p = (ii >= jj) ? acc[i] * ex2(lg * (float)(ii - jj)) : 0.f; PA[ii * 200 + jj] = (bf16)f2bf(p); } }
        else {
#pragma unroll
            for (int i = 0; i < 4; ++i) PA[(16 * w + 4 * q + i) * 200 + 16 * jt + r] = (bf16)0; }
    }
    __syncthreads();
    f32x4 o[4];
#pragma unroll
    for (int ct = 0; ct < 4; ++ct) o[ct] = tile16(PA, 200, Vt, 200, 16 * w, 16 * ct, 192, F.lane);
    float lng[4], lnb[4];
#pragma unroll
    for (int ct = 0; ct < 4; ++ct) { lng[ct] = F.rln_g[h * 64 + 16 * ct + r]; lnb[ct] = F.rln_b[h * 64 + 16 * ct + r]; }
#pragma unroll
    for (int i = 0; i < 4; ++i) { const int row = row0 + 16 * w + 4 * q + i;
        const float mean = sum16((o[0][i] + o[1][i]) + (o[2][i] + o[3][i])) * (1.f / 64);
        const float d0 = o[0][i] - mean, d1 = o[1][i] - mean, d2 = o[2][i] - mean, d3 = o[3][i] - mean;
        const float rstd = 1.0f / sqrtf(sum16((d0 * d0 + d1 * d1) + (d2 * d2 + d3 * d3)) * (1.f / 64) + EPS);
        const float dd[4] = {d0, d1, d2, d3};
#pragma unroll
        for (int ct = 0; ct < 4; ++ct) { float y = dd[ct] * rstd * lng[ct] + lnb[ct]; y *= bf2f(F.Gt[(size_t)row * 512 + h * 64 + 16 * ct + r]); F.MIX[(size_t)row * 1024 + 512 + h * 64 + 16 * ct + r] = (bf16)f2bf(y); } }
    __syncthreads();
}

__global__ void __launch_bounds__(512, 2) fwd_kernel(Args a) {
    extern __shared__ __attribute__((aligned(16))) unsigned char lds_raw[];
    Ctx F;
    F.lds = (LAS unsigned char*)lds_raw; F.tid = threadIdx.x; F.lane = F.tid & 63; F.wave = __builtin_amdgcn_readfirstlane(F.tid >> 6); F.G = gridDim.x; F.bid = blockIdx.x;
    F.xp = a.in[0]; F.xs = a.in[1]; F.cache = a.in[2]; F.state = a.in[3]; F.cp = a.in[4]; F.cs = a.in[5]; F.w_ada = a.in[6]; F.b_ada = a.in[7]; F.g_mix = a.in[8]; F.w_in = a.in[9]; F.conv_w = a.in[10]; F.conv_b = a.in[11];
    F.cln_g = a.in[12]; F.cln_b = a.in[13]; F.rln_g = a.in[14]; F.rln_b = a.in[15]; F.w_out = a.in[16]; F.g_ffn = a.in[17]; F.w_ff1 = a.in[18]; F.w_ff2 = a.in[19]; F.g_fin = a.in[20];
    F.out = a.out; unsigned char* ws = a.ws;
    F.Wt_in = (bf16*)(ws + WS_WIN); F.Wt_out = (bf16*)(ws + WS_WOUT); F.Wt_1 = (bf16*)(ws + WS_W1); F.Wt_2 = (bf16*)(ws + WS_W2); F.MOD = (float*)(ws + WS_MOD); F.cosT = (float*)(ws + WS_COS); F.sinT = (float*)(ws + WS_SIN);
    F.XN = (bf16*)(ws + WS_XN); F.U = (bf16*)(ws + WS_U); F.Q = (bf16*)(ws + WS_Q); F.K = (bf16*)(ws + WS_K); F.V = (bf16*)(ws + WS_V); F.Gt = (bf16*)(ws + WS_G); F.MIX = (bf16*)(ws + WS_MIX); F.L = (float*)(ws + WS_L); F.H = (bf16*)(ws + WS_H);
    const int lo = a.ph_lo, hi = a.ph_hi;
#define IN(k) (lo <= (k) && (k) < hi)
#define SEAM(k) do { if (IN(k) && IN((k) + 1)) cg::this_grid().sync(); } while (0)
    if (IN(0)) { p0_prologue(F); } SEAM(0);
    if (IN(1)) { modnorm_phase(F, F.xp, F.xs, F.g_mix, 0, 1024); } SEAM(1);
    if (IN(2)) { pg8::Gemm g{F.XN, F.Wt_in, M, DIN, D}; pg8::StaticOrder S; S.init(M, DIN, F.G, F.bid); pg8::EpiIn E{F.U, F.Q, F.K, F.V, F.Gt, F.cosT, F.sinT};
        pg8::gemm_phase<pg8::EpiIn, pg8::StaticOrder, true, true>(F.lds, g, S, E); } SEAM(2);
    if (IN(3)) { p3a_phase(F); } SEAM(3);
    if (IN(4)) { for (int u = F.bid; u < 1024; u += F.G) ret_out_unit(F, u); } SEAM(4);
    if (IN(5)) { pg8::Gemm g{F.MIX, F.Wt_out, M, D, D}; pg8::StaticOrder S; S.init(M, D, F.G, F.bid); pg8::EpiRes E{F.xp, F.xs, F.out, F.MOD + 2048};
        pg8::gemm_phase<pg8::EpiRes, pg8::StaticOrder, true, true>(F.lds, g, S, E); } SEAM(5);
    if (IN(6)) { modnorm_phase(F, F.out, F.out + (size_t)MP * D, F.g_ffn, 3072, 4096); } SEAM(6);
    if (IN(7)) { pg8::Gemm g{F.XN, F.Wt_1, M, FF, D}; pg8::StaticOrder S; S.init(M, FF, F.G, F.bid); pg8::EpiFF1 E{F.H};
        pg8::gemm_phase<pg8::EpiFF1, pg8::StaticOrder, true, true>(F.lds, g, S, E); } SEAM(7);
    if (IN(8)) { pg8::Gemm g{F.H, F.Wt_2, M, D, FF}; pg8::StaticOrder S; S.init(M, D, F.G, F.bid); pg8::EpiRes E{F.out, F.out + (size_t)MP * D, F.out, F.MOD + 5120};
        pg8::gemm_phase<pg8::EpiRes, pg8::StaticOrder, true, true>(F.lds, g, S, E); } SEAM(8);
    if (IN(9)) { final_norm_phase(F); }
#undef IN
#undef SEAM
}

extern "C" void kernel_launch(void* const* d_in, const int* in_sizes, int n_in, void* d_out, int out_size, void* d_ws, size_t ws_size, hipStream_t stream) {
    static int grid = 0;
    if (grid == 0) {
        if (n_in != 21 || (size_t)out_size != OUT_END || ws_size < WS_END) { fprintf(stderr, "kernel_launch: unexpected shapes: n_in %d out %d ws %zu\n", n_in, out_size, ws_size); grid = -1; return; }
        int dev = 0, cus = 0, per_cu = 0;
        (void)hipGetDevice(&dev); (void)hipDeviceGetAttribute(&cus, hipDeviceAttributeMultiprocessorCount, dev);
        if (hipFuncSetAttribute((const void*)fwd_kernel, hipFuncAttributeMaxDynamicSharedMemorySize, LDS_BYTES) != hipSuccess) { fprintf(stderr, "kernel_launch: hipFuncSetAttribute failed\n"); grid = -1; return; }
        if (hipOccupancyMaxActiveBlocksPerMultiprocessor(&per_cu, (const void*)fwd_kernel, 512, LDS_BYTES) != hipSuccess || per_cu < 1) { fprintf(stderr, "kernel_launch: occupancy query says %d\n", per_cu); per_cu = 1; }
        (void)hipGetLastError();
        grid = cus * per_cu;
    }
    if (grid < 0) return;
    Args a{};
    for (int i = 0; i < 21; ++i) a.in[i] = (const float*)d_in[i];
    a.out = (float*)d_out; a.ws = (unsigned char*)d_ws;
#if MK_ONE_LAUNCH
    a.ph_lo = 0; a.ph_hi = NPHASE;
    void* args[] = {&a};
    hipError_t e = hipLaunchCooperativeKernel((const void*)fwd_kernel, dim3(grid), dim3(512), args, LDS_BYTES, stream);
    if (e != hipSuccess) fprintf(stderr, "cooperative launch failed: %s (grid %d)\n", hipGetErrorString(e), grid);
#else
    for (int p = 0; p < NPHASE; ++p) { a.ph_lo = p; a.ph_hi = p + 1; hipLaunchKernelGGL(fwd_kernel, dim3(grid), dim3(512), LDS_BYTES, stream, a); }
#endif
}
```

```cpp
#include <hip/hip_runtime.h>
#include <hip/hip_cooperative_groups.h>
#include <cstdio>
#include <cstdint>
namespace pg8 {
#define PG8_LAS __attribute__((address_space(3)))
typedef unsigned short bf16_t;
typedef short bf16x8 __attribute__((ext_vector_type(8)));
typedef float f32x4 __attribute__((ext_vector_type(4)));
typedef unsigned u32x4 __attribute__((ext_vector_type(4)));
constexpr int BM = 256, BK = 64, HALF = 128, HTB = HALF * BK * 2  , STAGE_BYTES = 8 * HTB, NXCD = 8, WGM = 8;

__host__ __device__ __forceinline__ int lds_byte(int r, int c) { const int st = (r >> 4) * 2 + (c >> 5), rr = r & 15, cc = c & 31, ob = rr * 64 + cc * 2; return st * 1024 + (ob ^ (((ob >> 9) & 1) << 5)); }
__host__ __device__ __forceinline__ void stage_rc(int b, int& R, int& C) { const int st = b / 1024, sb = b % 1024, swz = sb ^ (((sb >> 9) & 1) << 5); R = (st >> 1) * 16 + swz / 64; C = (st & 1) * 32 + (swz % 64) / 2; }
__host__ __device__ __forceinline__ int perm32(int rho) { const int n = rho >> 4, i = rho & 15; return 8 * (i >> 2) + 4 * n + (i & 3); }

struct Unit { int pm, pn; };
struct Gemm { const bf16_t* A; const bf16_t* Bt; int M, N, K; };

struct StaticOrder {
    int nM, nN, nwg, G, c;
    __host__ __device__ void init(int M, int N, int G_, int c_) { nM = M / BM; nN = N / BM; nwg = nM * nN; G = G_; c = c_; }
    __host__ __device__ bool next(int i, Unit& u) const {
        const long L = (long)i * G + c; if (L >= nwg) return false;
        int wgid = (int)L; { const int q = nwg / NXCD, r = nwg % NXCD, xcd = wgid % NXCD, off = wgid / NXCD; wgid = (xcd < r ? xcd * (q + 1) : r * (q + 1) + (xcd - r) * q) + off; }
        const int nig = WGM * nN, gid = wgid / nig, fm = gid * WGM, gsz = (nM - fm) < WGM ? (nM - fm) : WGM;
        u.pm = fm + ((wgid % nig) % gsz); u.pn = (wgid % nig) / gsz; return true;
    }
    __device__ __forceinline__ void a_ready(const Unit&) const {}
    __device__ __forceinline__ void done(const Unit&) const {}
};

__device__ __forceinline__ unsigned cvt_pk_bf16(float lo, float hi) { unsigned r; asm volatile("v_cvt_pk_bf16_f32 %0, %1, %2" : "=v"(r) : "v"(lo), "v"(hi)); return r; }
typedef float f32x2 __attribute__((ext_vector_type(2)));
__device__ __forceinline__ float sigmoid_f(float x) { return __builtin_amdgcn_rcpf(1.0f + __expf(-x)); }
__device__ __forceinline__ int bidx_of_row(int r) { return r < 16384 ? (r >> 11) : 8 + ((r - 16384) >> 2); }
__device__ __forceinline__ int posidx_of_row(int r) { return r < 16384 ? (r & 2047) : 2048 + ((r - 16384) & 3); }

struct EpiIn {
    static constexpr bool PERM = true, AFTER_DRAIN = false;
    bf16_t *U, *Q, *Kb, *V, *G; const float* cosT; const float* sinT;
    __device__ __forceinline__ void operator()(const f32x4 (&acc)[2][2][4][2], const Unit& u, int wr, int wc, int fr, int fq) const {
        const int row0 = u.pm * BM + wr * 64 + fr; const int o0 = wc * 32 + 8 * fq; const int pn = u.pn;
        if (pn < 4) {
#pragma unroll
            for (int ai = 0; ai < 2; ++ai)
#pragma unroll
                for (int m = 0; m < 4; ++m) { const int r = row0 + ai * HALF + m * 16;
                    const f32x4 a0 = acc[ai][0][m][0], a1 = acc[ai][0][m][1], b0 = acc[ai][1][m][0], b1 = acc[ai][1][m][1];
                    u32x4 w; w.x = cvt_pk_bf16(a0[0] * sigmoid_f(b0[0]), a0[1] * sigmoid_f(b0[1])); w.y = cvt_pk_bf16(a0[2] * sigmoid_f(b0[2]), a0[3] * sigmoid_f(b0[3]));
                    w.z = cvt_pk_bf16(a1[0] * sigmoid_f(b1[0]), a1[1] * sigmoid_f(b1[1])); w.w = cvt_pk_bf16(a1[2] * sigmoid_f(b1[2]), a1[3] * sigmoid_f(b1[3]));
                    *(u32x4*)(U + (size_t)r * 512 + 128 * pn + o0) = w; }
        } else if (pn < 8) {
            const bool isq = pn < 6; bf16_t* base = isq ? Q : Kb; const float sc = isq ? 0.125f : 1.0f;
            const int colb = (4 * ((pn - 4) & 1) + wc) * 64 + 8 * fq;
#pragma unroll
            for (int ai = 0; ai < 2; ++ai)
#pragma unroll
                for (int m = 0; m < 4; ++m) { const int r = row0 + ai * HALF + m * 16; const int pi = posidx_of_row(r);
                    const f32x4 c0 = *(const f32x4*)(cosT + pi * 32 + 8 * fq), c1 = *(const f32x4*)(cosT + pi * 32 + 8 * fq + 4);
                    const f32x4 s0 = *(const f32x4*)(sinT + pi * 32 + 8 * fq), s1 = *(const f32x4*)(sinT + pi * 32 + 8 * fq + 4);
                    const f32x4 x10 = acc[ai][0][m][0], x11 = acc[ai][0][m][1], x20 = acc[ai][1][m][0], x21 = acc[ai][1][m][1];
                    const f32x4 p0 = (x10 * c0 - x20 * s0) * sc, p1 = (x11 * c1 - x21 * s1) * sc, q0 = (x10 * s0 + x20 * c0) * sc, q1 = (x11 * s1 + x21 * c1) * sc;
                    u32x4 w; w.x = cvt_pk_bf16(p0[0], p0[1]); w.y = cvt_pk_bf16(p0[2], p0[3]); w.z = cvt_pk_bf16(p1[0], p1[1]); w.w = cvt_pk_bf16(p1[2], p1[3]);
                    *(u32x4*)(base + (size_t)r * 512 + colb) = w;
                    w.x = cvt_pk_bf16(q0[0], q0[1]); w.y = cvt_pk_bf16(q0[2], q0[3]); w.z = cvt_pk_bf16(q1[0], q1[1]); w.w = cvt_pk_bf16(q1[2], q1[3]);
                    *(u32x4*)(base + (size_t)r * 512 + colb + 32) = w; }
        } else {
            const bool isg = pn >= 10; bf16_t* base = isg ? G : V; const int colb = 256 * ((pn - 8) & 1) + o0;
#pragma unroll
            for (int ai = 0; ai < 2; ++ai)
#pragma unroll
                for (int m = 0; m < 4; ++m) { const int r = row0 + ai * HALF + m * 16;
#pragma unroll
                    for (int bj = 0; bj < 2; ++bj) { f32x4 v0 = acc[ai][bj][m][0], v1 = acc[ai][bj][m][1];
                        if (isg) {
#pragma unroll
                            for (int e = 0; e < 4; ++e) { v0[e] = v0[e] * sigmoid_f(v0[e]); v1[e] = v1[e] * sigmoid_f(v1[e]); } }
                        u32x4 w; w.x = cvt_pk_bf16(v0[0], v0[1]); w.y = cvt_pk_bf16(v0[2], v0[3]); w.z = cvt_pk_bf16(v1[0], v1[1]); w.w = cvt_pk_bf16(v1[2], v1[3]);
                        *(u32x4*)(base + (size_t)r * 512 + colb + bj * HALF) = w; } }
        }
    }
};

struct EpiRes {
    static constexpr bool PERM = false, AFTER_DRAIN = false;
    const float* xp; const float* xs; float* out; const float* gate;
    __device__ __forceinline__ void operator()(const f32x4 (&acc)[2][2][4][2], const Unit& u, int wr, int wc, int fr, int fq) const {
        const int col0 = u.pn * BM + wc * 32 + 4 * fq;
#pragma unroll
        for (int ai = 0; ai < 2; ++ai)
#pragma unroll
            for (int m = 0; m < 4; ++m) { const int r = u.pm * BM + ai * HALF + wr * 64 + m * 16 + fr;
                const float* xr = r < 16384 ? xp + (size_t)r * 1024 : xs + (size_t)(r - 16384) * 1024; const float* gr = gate + (size_t)bidx_of_row(r) * 6144;
#pragma unroll
                for (int bj = 0; bj < 2; ++bj)
#pragma unroll
                    for (int n = 0; n < 2; ++n) { const int c = col0 + bj * HALF + n * 16;
                        const f32x4 xv = *(const f32x4*)(xr + c), gv = *(const f32x4*)(gr + c);
                        *(f32x4*)(out + (size_t)r * 1024 + c) = xv + gv * acc[ai][bj][m][n]; } }
    }
};

struct EpiFF1 {
    static constexpr bool PERM = true, AFTER_DRAIN = false;
    bf16_t* H;
    __device__ __forceinline__ void operator()(const f32x4 (&acc)[2][2][4][2], const Unit& u, int wr, int wc, int fr, int fq) const {
        const int row0 = u.pm * BM + wr * 64 + fr; const int col0 = u.pn * BM + wc * 32 + 8 * fq;
#pragma unroll
        for (int ai = 0; ai < 2; ++ai)
#pragma unroll
            for (int m = 0; m < 4; ++m) { bf16_t* rowp = H + (size_t)(row0 + ai * HALF + m * 16) * 4096 + col0;
#pragma unroll
                for (int bj = 0; bj < 2; ++bj) { f32x4 v0 = acc[ai][bj][m][0], v1 = acc[ai][bj][m][1];
#pragma unroll
                    for (int e = 0; e < 4; ++e) { const float a = fmaxf(v0[e], 0.f), b = fmaxf(v1[e], 0.f); v0[e] = a * a; v1[e] = b * b; }
                    u32x4 w; w.x = cvt_pk_bf16(v0[0], v0[1]); w.y = cvt_pk_bf16(v0[2], v0[3]); w.z = cvt_pk_bf16(v1[0], v1[1]); w.w = cvt_pk_bf16(v1[2], v1[3]);
                    *(u32x4*)(rowp + bj * HALF) = w; } }
    }
};

template <class Epi, class Sched, bool ALIGN_EPI = false, bool SP2 = false>
__device__ __forceinline__ void gemm_phase(PG8_LAS unsigned char* lds, const Gemm g, const Sched& S, const Epi& E) {
    const int tid = threadIdx.x, wid = __builtin_amdgcn_readfirstlane(tid >> 6), lane = tid & 63, wr = wid >> 2, wc = wid & 3, fr = lane & 15, fq = lane >> 4;
    const int K = g.K, nt = K / BK;
    unsigned voffA[2], voffB[2];
#pragma unroll
    for (int i = 0; i < 2; ++i) { int R, C; stage_rc(tid * 16 + i * 8192, R, C); const int Rb = Epi::PERM ? ((R & ~31) + perm32(R & 31)) : R;
        voffA[i] = (unsigned)(R * K + C) * 2u; voffB[i] = (unsigned)(Rb * K + C) * 2u; }
    const size_t kstep = (size_t)(BK * 2);
    const size_t hstep = (size_t)HALF * K * 2;
    const size_t tstep = 2 * hstep;
    const unsigned ldsw = (unsigned)wid * 1024u;
    const int aoff = lds_byte(wr * 64 + fr, fq * 8), boff = lds_byte(wc * 32 + fr, fq * 8);
#define PG8_SA(b, h) (((b) * 2 + (h)) * HTB)
#define PG8_SB(b, h) ((4 + (b) * 2 + (h)) * HTB)
#define PG8_STAGE(bufoff, gbase, voff) do { _Pragma("unroll") for (int _i = 0; _i < 2; ++_i) \
        __builtin_amdgcn_global_load_lds((const unsigned*)((const char*)(gbase) + (voff)[_i]), (PG8_LAS unsigned*)(lds + (bufoff) + ldsw + _i * 8192), 16, 0, 0); } while (0)
#define PG8_LDA(dst, b, h) do { _Pragma("unroll") for (int m = 0; m < 4; ++m) _Pragma("unroll") for (int k = 0; k < 2; ++k) dst[m][k] = *(const PG8_LAS bf16x8*)(lds + PG8_SA(b, h) + aoff + m * 2048 + k * 1024); } while (0)
#define PG8_LDB(dst, b, h) do { _Pragma("unroll") for (int n = 0; n < 2; ++n) _Pragma("unroll") for (int k = 0; k < 2; ++k) dst[n][k] = *(const PG8_LAS bf16x8*)(lds + PG8_SB(b, h) + boff + n * 2048 + k * 1024); } while (0)
#define PG8_MMA(ai, bj, At, Bt) do { __builtin_amdgcn_s_setprio(1); _Pragma("unroll") for (int m = 0; m < 4; ++m) _Pragma("unroll") for (int n = 0; n < 2; ++n) _Pragma("unroll") for (int k = 0; k < 2; ++k) \
        acc[ai][bj][m][n] = __builtin_amdgcn_mfma_f32_16x16x32_bf16(Bt[n][k], At[m][k], acc[ai][bj][m][n], 0, 0, 0); __builtin_amdgcn_s_setprio(0); } while (0)
#define PG8_WAIT_V(n) asm volatile("s_waitcnt vmcnt(" #n ")" ::: "memory")
#define PG8_WAIT_L(n) asm volatile("s_waitcnt lgkmcnt(" #n ")" ::: "memory")
#define PG8_BAR __builtin_amdgcn_s_barrier()
#define PG8_SCHED __builtin_amdgcn_sched_barrier(0)
    Unit cur, nxt; int ui = 0;
    if (!S.next(0, cur)) return;
    f32x4 acc[2][2][4][2];
#pragma unroll
    for (int a = 0; a < 2; ++a)
#pragma unroll
        for (int b = 0; b < 2; ++b)
#pragma unroll
            for (int m = 0; m < 4; ++m)
#pragma unroll
                for (int n = 0; n < 2; ++n) acc[a][b][m][n] = (f32x4){0.f, 0.f, 0.f, 0.f};
    bf16x8 At[4][2], B0[2][2], B1[2][2];
    const char* cA = (const char*)g.A + (size_t)cur.pm * tstep; const char* cB = (const char*)g.Bt + (size_t)cur.pn * tstep;
    S.a_ready(cur);
    if constexpr (SP2) {
        PG8_STAGE(PG8_SB(0, 0), cB, voffB); PG8_STAGE(PG8_SB(0, 1), cB + hstep, voffB); PG8_STAGE(PG8_SA(0, 0), cA, voffA); PG8_STAGE(PG8_SA(0, 1), cA + hstep, voffA);
        if (wr == 1) PG8_BAR;
        PG8_WAIT_V(2); PG8_BAR;
        PG8_STAGE(PG8_SB(1, 0), cB + kstep, voffB); PG8_STAGE(PG8_SA(1, 0), cA + kstep, voffA); PG8_STAGE(PG8_SB(1, 1), cB + hstep + kstep, voffB);
        PG8_WAIT_V(6); PG8_BAR;
    } else {
        PG8_STAGE(PG8_SB(0, 0), cB, voffB); PG8_STAGE(PG8_SA(0, 0), cA, voffA); PG8_STAGE(PG8_SB(0, 1), cB + hstep, voffB); PG8_STAGE(PG8_SA(0, 1), cA + hstep, voffA);
        if (wr == 1) PG8_BAR;
        PG8_WAIT_V(4); PG8_BAR;
        PG8_STAGE(PG8_SB(1, 0), cB + kstep, voffB); PG8_STAGE(PG8_SA(1, 0), cA + kstep, voffA); PG8_STAGE(PG8_SB(1, 1), cB + hstep + kstep, voffB);
        PG8_WAIT_V(6); PG8_BAR;
    }
    for (;;) {
        const bool has_next = S.next(ui + 1, nxt);
        const char* nA = has_next ? (const char*)g.A + (size_t)nxt.pm * tstep : cA; const char* nB = has_next ? (const char*)g.Bt + (size_t)nxt.pn * tstep : cB;
        for (int t = 0; t < nt; t += 2) {
            const bool last = (t == nt - 2);
            const char* a1 = cA + (size_t)(t + 1) * kstep;
            const char* a2 = last ? nA : cA + (size_t)(t + 2) * kstep; const char* b2 = last ? nB : cB + (size_t)(t + 2) * kstep;
            const char* a3 = a2 + kstep; const char* b3 = b2 + kstep;
            if (last && has_next) S.a_ready(nxt);
            if constexpr (SP2) {
            PG8_LDB(B0, 0, 0); PG8_LDB(B1, 0, 1); PG8_SCHED; PG8_LDA(At, 0, 0); PG8_STAGE(PG8_SA(1, 1), a1 + hstep, voffA);
            PG8_WAIT_V(8); PG8_WAIT_L(0); PG8_BAR; PG8_MMA(0, 0, At, B0); PG8_MMA(0, 1, At, B1); PG8_BAR; PG8_SCHED;
            PG8_LDA(At, 0, 1); PG8_STAGE(PG8_SB(0, 0), b2, voffB); PG8_STAGE(PG8_SB(0, 1), b2 + hstep, voffB); PG8_STAGE(PG8_SA(0, 0), a2, voffA);
            PG8_WAIT_V(8); PG8_WAIT_L(0); PG8_BAR; PG8_MMA(1, 0, At, B0); PG8_MMA(1, 1, At, B1); PG8_BAR; PG8_SCHED;
            PG8_LDB(B0, 1, 0); PG8_LDB(B1, 1, 1); PG8_SCHED; PG8_LDA(At, 1, 0); PG8_STAGE(PG8_SA(0, 1), a2 + hstep, voffA);
            PG8_WAIT_V(8); PG8_WAIT_L(0); PG8_BAR; PG8_MMA(0, 0, At, B0); PG8_MMA(0, 1, At, B1); PG8_BAR; PG8_SCHED;
            PG8_LDA(At, 1, 1); PG8_STAGE(PG8_SB(1, 0), b3, voffB); PG8_STAGE(PG8_SB(1, 1), b3 + hstep, voffB); PG8_STAGE(PG8_SA(1, 0), a3, voffA);
            PG8_WAIT_V(8); PG8_WAIT_L(0); PG8_BAR; PG8_MMA(1, 0, At, B0); PG8_MMA(1, 1, At, B1); PG8_BAR; PG8_SCHED;
            } else {
            PG8_LDB(B0, 0, 0); PG8_SCHED; PG8_LDA(At, 0, 0); PG8_STAGE(PG8_SA(1, 1), a1 + hstep, voffA);
            PG8_WAIT_L(8); PG8_BAR; PG8_WAIT_L(0); PG8_MMA(0, 0, At, B0); PG8_BAR; PG8_SCHED;
            PG8_LDB(B1, 0, 1); PG8_STAGE(PG8_SB(0, 0), b2, voffB);
            PG8_BAR; PG8_WAIT_L(0); PG8_MMA(0, 1, At, B1); PG8_BAR;
            PG8_LDA(At, 0, 1); PG8_STAGE(PG8_SA(0, 0), a2, voffA);
            PG8_BAR; PG8_WAIT_L(0); PG8_MMA(1, 0, At, B0); PG8_BAR; PG8_SCHED;
            PG8_STAGE(PG8_SB(0, 1), b2 + hstep, voffB);
            PG8_WAIT_V(6); PG8_BAR; PG8_MMA(1, 1, At, B1); PG8_BAR;
            PG8_LDB(B0, 1, 0); PG8_SCHED; PG8_LDA(At, 1, 0); PG8_STAGE(PG8_SA(0, 1), a2 + hstep, voffA);
            PG8_WAIT_L(8); PG8_BAR; PG8_WAIT_L(0); PG8_MMA(0, 0, At, B0); PG8_BAR; PG8_SCHED;
            PG8_LDB(B1, 1, 1); PG8_STAGE(PG8_SB(1, 0), b3, voffB);
            PG8_BAR; PG8_WAIT_L(0); PG8_MMA(0, 1, At, B1); PG8_BAR;
            PG8_LDA(At, 1, 1); PG8_STAGE(PG8_SA(1, 0), a3, voffA);
            PG8_BAR; PG8_WAIT_L(0); PG8_MMA(1, 0, At, B0); PG8_BAR; PG8_SCHED;
            PG8_STAGE(PG8_SB(1, 1), b3 + hstep, voffB);
            PG8_WAIT_V(6); PG8_BAR; PG8_MMA(1, 1, At, B1); PG8_BAR;
            }
        }
        if constexpr (ALIGN_EPI) { if (wr == 0) PG8_BAR; }
        if constexpr (!Epi::AFTER_DRAIN) { E(acc, cur, wr, wc, fr, fq); S.done(cur); }
        if (!has_next) break;
#pragma unroll
        for (int a = 0; a < 2; ++a)
#pragma unroll
            for (int b = 0; b < 2; ++b)
#pragma unroll
                for (int m = 0; m < 4; ++m)
#pragma unroll
                    for (int n = 0; n < 2; ++n) acc[a][b][m][n] = (f32x4){0.f, 0.f, 0.f, 0.f};
        cur = nxt; cA = nA; cB = nB; ++ui;
        if constexpr (ALIGN_EPI) { if (wr == 1) PG8_BAR; }
    }
    PG8_WAIT_V(0);
    if constexpr (!ALIGN_EPI) { if (wr == 0) PG8_BAR; }
    PG8_BAR;
    if constexpr (Epi::AFTER_DRAIN) { E.fused(acc, cur, wr, wc, fr, fq, lds, wid, lane); S.done(cur); }
#undef PG8_SA
#undef PG8_SB
#undef PG8_STAGE
#undef PG8_LDA
#undef PG8_LDB
#undef PG8_MMA
#undef PG8_WAIT_V
#undef PG8_WAIT_L
#undef PG8_BAR
#undef PG8_SCHED
}
}
namespace cg = cooperative_groups;
#define LAS __attribute__((address_space(3)))
#define DI __device__ __forceinline__
typedef unsigned short bf16;
typedef float f32x4 __attribute__((ext_vector_type(4)));
typedef float f32x16 __attribute__((ext_vector_type(16)));
typedef short bf16x8 __attribute__((ext_vector_type(8)));
typedef unsigned u32x4 __attribute__((ext_vector_type(4)));
typedef unsigned u32x2 __attribute__((ext_vector_type(2)));

#ifndef MK_ONE_LAUNCH
#define MK_ONE_LAUNCH 1
#endif
constexpr int NPHASE = 10;
constexpr int D = 1024, MP = 16384, MS = 512, M = MP + MS, DIN = 3072, FF = 4096, NB = 136, NMOD = 6144;
constexpr float EPS = 1e-6f;
constexpr size_t MiB = 1u << 20;
constexpr size_t SZ512 = (size_t)M * 512 * 2;
constexpr size_t WS_WIN = 1 * MiB, WS_WOUT = 7 * MiB, WS_W1 = 9 * MiB, WS_W2 = 17 * MiB, WS_MOD = 25 * MiB, WS_COS = 29 * MiB, WS_SIN = 29 * MiB + 512 * 1024, WS_XN = 30 * MiB;
constexpr size_t WS_U = 63 * MiB, WS_Q = WS_U + SZ512, WS_K = WS_Q + SZ512, WS_V = WS_K + SZ512, WS_G = WS_V + SZ512, WS_MIX = WS_G + SZ512, WS_L = WS_MIX + (size_t)M * 1024 * 2, WS_H = 63 * MiB;
constexpr size_t WS_END = WS_L + 16 * MiB;
static_assert(WS_XN + (size_t)M * D * 2 <= WS_U && WS_H + (size_t)M * FF * 2 <= 256 * MiB && WS_END <= 256 * MiB, "d_ws map");
constexpr size_t OUT_Y = 0, OUT_CONVP = (size_t)M * D, OUT_RETP = OUT_CONVP + 8 * 30 * 512, OUT_CONVS = OUT_RETP + 8 * 8 * 4096, OUT_RETS = OUT_CONVS + 128 * 30 * 512, OUT_END = OUT_RETS + (size_t)128 * 8 * 4096;
constexpr int LDS_BYTES = 147456;

__device__ const double INV_FREQ[32] = {1.0, 0.7498942093324559, 0.5623413251903491, 0.4216965034285822, 0.31622776601683794, 0.23713737056616552, 0.1778279410038923, 0.1333521432163324, 0.1, 0.07498942093324558, 0.05623413251903491, 0.042169650342858224, 0.03162277660168379, 0.023713737056616554, 0.01778279410038923, 0.01333521432163324, 0.01, 0.007498942093324558, 0.005623413251903491, 0.004216965034285823, 0.0031622776601683794, 0.0023713737056616554, 0.0017782794100389228, 0.001333521432163324, 0.001, 0.0007498942093324559, 0.0005623413251903491, 0.00042169650342858224, 0.00031622776601683794, 0.00023713737056616554, 0.00017782794100389227, 0.0001333521432163324};
__device__ const float LOG2G[8] = {-0.04580368961312479f, -0.02272007650008353f, -0.011315313227834146f, -0.005646563141142063f, -0.0028205190623786626f, -0.0014095702546713536f, -0.0007046129765893727f, -0.0003522634716290214f};

#define LDS_WAIT() asm volatile("s_waitcnt lgkmcnt(0)" ::: "memory")
DI unsigned f2bf(float f) { unsigned u = __builtin_bit_cast(unsigned, f); return (u + 0x7fffu + ((u >> 16) & 1u)) >> 16; }
DI unsigned pk2(float lo, float hi) { return f2bf(lo) | (f2bf(hi) << 16); }
DI float bf2f(unsigned h) { return __builtin_bit_cast(float, h << 16); }
DI float bflo(unsigned w) { return __builtin_bit_cast(float, w << 16); }
DI float bfhi(unsigned w) { return __builtin_bit_cast(float, w & 0xffff0000u); }
DI float sigm(float x) { return __builtin_amdgcn_rcpf(1.0f + __expf(-x)); }
DI float ex2(float x) { return __builtin_amdgcn_exp2f(x); }
DI float wave_sum(float v) {
#pragma unroll
    for (int o = 1; o < 64; o <<= 1) v += __shfl_xor(v, o);
    return v;
}
DI float sum16(float v) { v += __shfl_xor(v, 1); v += __shfl_xor(v, 2); v += __shfl_xor(v, 4); v += __shfl_xor(v, 8); return v; }

struct Args { const float* in[21]; float* out; unsigned char* ws; int ph_lo, ph_hi; };
struct Ctx {
    LAS unsigned char* lds; int tid, lane, wave, G, bid;
    const float *xp, *xs, *cache, *state, *cp, *cs, *w_ada, *b_ada, *g_mix, *w_in, *conv_w, *conv_b, *cln_g, *cln_b, *rln_g, *rln_b, *w_out, *g_ffn, *w_ff1, *w_ff2, *g_fin;
    float* out; bf16 *Wt_in, *Wt_out, *Wt_1, *Wt_2, *XN, *U, *Q, *K, *V, *Gt, *MIX, *H; float *MOD, *cosT, *sinT, *L;
};

DI f32x4 tile16(const LAS bf16* A, int lda, const LAS bf16* Bt, int ldb, int m0, int n0, int K, int lane) {
    const int r = lane & 15, q = lane >> 4; f32x4 acc = {0.f, 0.f, 0.f, 0.f};
    const LAS bf16* ap = A + (m0 + r) * lda + q * 8; const LAS bf16* bp = Bt + (n0 + r) * ldb + q * 8;
    for (int k = 0; k < K; k += 32) { const bf16x8 a = *(const LAS bf16x8*)(ap + k); const bf16x8 b = *(const LAS bf16x8*)(bp + k); acc = __builtin_amdgcn_mfma_f32_16x16x32_bf16(a, b, acc, 0, 0, 0); }
    return acc;
}

DI int win_dest_row(int c0) {
    if (c0 < 512) return 256 * (c0 >> 7) + (c0 & 127);
    if (c0 < 1024) { const int c = c0 - 512; return 256 * (c >> 7) + 128 + (c & 127); }
    if (c0 < 2048) { const int grp = (c0 - 1024) >> 9, c = (c0 - 1024) & 511, head = c >> 6, half = (c >> 5) & 1; return 256 * (4 + 2 * grp + (head >> 2)) + 128 * half + 32 * (head & 3); }
    return c0;
}
DI void p0_transpose_item(const float* W, int K, int N, bf16* WT, bool win, LAS float* scr, int item, int lane) {
    const int nblk = N / 32, kb = item / nblk, nb = item % nblk, k0 = 64 * kb, n0 = 32 * nb;
    const int drow = win ? win_dest_row(n0) : n0;
#pragma unroll 8
    for (int i = 0; i < 32; ++i) { const int kk = 2 * i + (lane >> 5); scr[kk * 33 + (lane & 31)] = W[(size_t)(k0 + kk) * N + n0 + (lane & 31)]; }
    LDS_WAIT();
    const int c = lane & 7;
#pragma unroll
    for (int j = 0; j < 4; ++j) { const int n = (lane >> 3) + 8 * j; const LAS float* s = scr + (8 * c) * 33 + n;
        u32x4 o; o.x = pk2(s[0 * 33], s[1 * 33]); o.y = pk2(s[2 * 33], s[3 * 33]); o.z = pk2(s[4 * 33], s[5 * 33]); o.w = pk2(s[6 * 33], s[7 * 33]);
        *(u32x4*)(WT + (size_t)(drow + n) * K + k0 + 8 * c) = o; }
    LDS_WAIT();
}
DI void p0_mod(const Ctx& F) {
    for (int cb = F.bid; cb < 192; cb += F.G) {
    const int n0 = 32 * cb; LAS float* OUT = (LAS float*)F.lds;
    const int r32 = F.lane & 31, hi = F.lane >> 5, k0 = F.wave * 128 + 8 * hi;
    f32x16 acc[5];
#pragma unroll
    for (int mt = 0; mt < 5; ++mt)
#pragma unroll
        for (int i = 0; i < 16; ++i) acc[mt][i] = 0.f;
    const float* crow[5];
#pragma unroll
    for (int mt = 0; mt < 5; ++mt) { const int r = mt * 32 + r32; crow[mt] = (r < 8 ? F.cp + (size_t)r * D : F.cs + (size_t)((r < NB ? r : 8) - 8) * D) + k0; }
    const bool v4 = (128 + r32) < NB;
#pragma unroll 1
    for (int kh = 0; kh < 2; ++kh) {
        float bw[4][8];
#pragma unroll
        for (int ks = 0; ks < 4; ++ks)
#pragma unroll
            for (int j = 0; j < 8; ++j) bw[ks][j] = F.w_ada[(size_t)(k0 + (kh * 4 + ks) * 16 + j) * NMOD + n0 + r32];
#pragma unroll
        for (int ks = 0; ks < 4; ++ks) {
            bf16x8 b;
#pragma unroll
            for (int j = 0; j < 8; ++j) b[j] = (short)f2bf(bw[ks][j]);
            f32x4 x0[5], x1[5];
#pragma unroll
            for (int mt = 0; mt < 5; ++mt) { x0[mt] = *(const f32x4*)(crow[mt] + (kh * 4 + ks) * 16); x1[mt] = *(const f32x4*)(crow[mt] + (kh * 4 + ks) * 16 + 4); }
#pragma unroll
            for (int mt = 0; mt < 5; ++mt) { bf16x8 a;
#pragma unroll
                for (int j = 0; j < 4; ++j) { a[j] = (short)f2bf(x0[mt][j] * sigm(x0[mt][j])); a[4 + j] = (short)f2bf(x1[mt][j] * sigm(x1[mt][j])); }
                if (mt == 4 && !v4) a = (bf16x8){0, 0, 0, 0, 0, 0, 0, 0};
                acc[mt] = __builtin_amdgcn_mfma_f32_32x32x16_bf16(a, b, acc[mt], 0, 0, 0); }
        }
    }
    for (int w = 0; w < 8; ++w) {
        if (F.wave == w) {
#pragma unroll
            for (int mt = 0; mt < 5; ++mt)
#pragma unroll
                for (int i = 0; i < 16; ++i) { const int row = mt * 32 + (i & 3) + 8 * (i >> 2) + 4 * hi; const float prev = (w == 0) ? 0.f : OUT[row * 32 + r32]; OUT[row * 32 + r32] = prev + acc[mt][i]; }
        }
        __syncthreads();
    }
    for (int i = F.tid; i < NB * 32; i += 512) { const int r = i >> 5, c = i & 31; F.MOD[(size_t)r * NMOD + n0 + c] = OUT[i] + F.b_ada[n0 + c]; }
    __syncthreads();
    }
}
constexpr int I_IN = (D / 64) * (DIN / 32), I_O = (D / 64) * (D / 32), I_1 = (D / 64) * (FF / 32), I_2 = (FF / 64) * (D / 32), NITEMS = I_IN + I_O + I_1 + I_2;
constexpr int EARLY_ITEMS = 1024;
DI void transpose_items(const Ctx& F, int first, int last, int gw, int ngw) {
    LAS float* scr = (LAS float*)(F.lds + F.wave * 16384);
    for (int it = first + gw; it < last; it += ngw) { int r = it;
        if (r < I_IN) { p0_transpose_item(F.w_in, D, DIN, F.Wt_in, true, scr, r, F.lane); continue; } r -= I_IN;
        if (r < I_O) { p0_transpose_item(F.w_out, D, D, F.Wt_out, false, scr, r, F.lane); continue; } r -= I_O;
        if (r < I_1) { p0_transpose_item(F.w_ff1, D, FF, F.Wt_1, false, scr, r, F.lane); continue; } r -= I_1;
        p0_transpose_item(F.w_ff2, FF, D, F.Wt_2, false, scr, r, F.lane); }
}
DI void p0_prologue(const Ctx& F) {
    if (F.G == 256) { if (F.bid < 192) p0_mod(F); else transpose_items(F, 0, EARLY_ITEMS, (F.bid - 192) * 8 + F.wave, 64 * 8); }
    else { p0_mod(F); transpose_items(F, 0, EARLY_ITEMS, F.bid * 8 + F.wave, F.G * 8); }
}
DI void p1_tables(const Ctx& F) {
    for (int i = F.bid * 512 + F.tid; i < 2052 * 32; i += F.G * 512) { const int p = i >> 5, d = i & 31; const double pos = p < 2048 ? (double)p : (double)(16384 + (p - 2048));
        double rev = pos * INV_FREQ[d] * 0.15915494309189535; rev -= floor(rev); const float fr = (float)rev; F.cosT[i] = __builtin_amdgcn_cosf(fr); F.sinT[i] = __builtin_amdgcn_sinf(fr); }
    transpose_items(F, EARLY_ITEMS, NITEMS, F.bid * 8 + F.wave, F.G * 8);
}

DI void modnorm_phase(const Ctx& F, const float* x0, const float* x1, const float* g, int sh_off, int sc_off) {
    const int gw = F.bid * 8 + F.wave, NGW = F.G * 8;
    for (int m0 = gw * 4; m0 < M; m0 += NGW * 4) {
        f32x4 v[4][4];
#pragma unroll
        for (int rr = 0; rr < 4; ++rr) { const int m = m0 + rr; const float* xrow = m < MP ? x0 + (size_t)m * D : x1 + (size_t)(m - MP) * D; const f32x4* xr = (const f32x4*)xrow + F.lane;
#pragma unroll
            for (int j = 0; j < 4; ++j) v[rr][j] = xr[64 * j]; }
#pragma unroll
        for (int rr = 0; rr < 4; ++rr) { const int m = m0 + rr; const float* mod = F.MOD + (size_t)pg8::bidx_of_row(m) * NMOD; float s = 0.f;
#pragma unroll
            for (int j = 0; j < 4; ++j) s += (v[rr][j].x * v[rr][j].x + v[rr][j].y * v[rr][j].y) + (v[rr][j].z * v[rr][j].z + v[rr][j].w * v[rr][j].w);
            const float rstd = 1.0f / sqrtf(wave_sum(s) * (1.f / D) + EPS);
            u32x2* o8 = (u32x2*)(F.XN + (size_t)m * D) + F.lane;
#pragma unroll
            for (int j = 0; j < 4; ++j) { const f32x4 gv = ((const f32x4*)g)[F.lane + 64 * j], sh = ((const f32x4*)(mod + sh_off))[F.lane + 64 * j], sc = ((const f32x4*)(mod + sc_off))[F.lane + 64 * j];
                const f32x4 y = v[rr][j] * rstd * gv * (sc + 1.0f) + sh; u32x2 w; w.x = pk2(y.x, y.y); w.y = pk2(y.z, y.w); o8[64 * j] = w; } }
    }
}
DI void final_norm_phase(const Ctx& F) {
    const int gw = F.bid * 8 + F.wave, NGW = F.G * 8;
    f32x4 gf[4];
#pragma unroll
    for (int j = 0; j < 4; ++j) gf[j] = ((const f32x4*)F.g_fin)[F.lane + 64 * j];
    for (int m0 = gw * 4; m0 < M; m0 += NGW * 4) {
        f32x4 v[4][4];
#pragma unroll
        for (int rr = 0; rr < 4; ++rr) { f32x4* xr = (f32x4*)(F.out + (size_t)(m0 + rr) * D) + F.lane;
#pragma unroll
            for (int j = 0; j < 4; ++j) v[rr][j] = xr[64 * j]; }
#pragma unroll
        for (int rr = 0; rr < 4; ++rr) { f32x4* xr = (f32x4*)(F.out + (size_t)(m0 + rr) * D) + F.lane; float s = 0.f;
#pragma unroll
            for (int j = 0; j < 4; ++j) s += (v[rr][j].x * v[rr][j].x + v[rr][j].y * v[rr][j].y) + (v[rr][j].z * v[rr][j].z + v[rr][j].w * v[rr][j].w);
            const float rstd = 1.0f / sqrtf(wave_sum(s) * (1.f / D) + EPS);
#pragma unroll
            for (int j = 0; j < 4; ++j) xr[64 * j] = v[rr][j] * rstd * gf[j]; }
    }
}

DI void ret_local_unit(const Ctx& F, int uid) {
    const int b = uid >> 7, h = (uid >> 4) & 7, n = uid & 15, row0 = b * 2048 + n * 128; const float lg = LOG2G[h];
    LAS bf16* KT = (LAS bf16*)F.lds; LAS bf16* VT = (LAS bf16*)(F.lds + 17408);
    { const int j = F.tid >> 2, d0 = (F.tid & 3) * 16; const float f = ex2(lg * (float)(127 - j));
      const u32x4* kp = (const u32x4*)(F.K + (size_t)(row0 + j) * 512 + h * 64 + d0); const u32x4* vp = (const u32x4*)(F.V + (size_t)(row0 + j) * 512 + h * 64 + d0);
      const u32x4 k0 = kp[0], k1 = kp[1], v0 = vp[0], v1 = vp[1];
#pragma unroll
      for (int e = 0; e < 4; ++e) {
          KT[(d0 + 2 * e) * 136 + j] = (bf16)f2bf(bflo(k0[e]) * f); KT[(d0 + 2 * e + 1) * 136 + j] = (bf16)f2bf(bfhi(k0[e]) * f);
          KT[(d0 + 8 + 2 * e) * 136 + j] = (bf16)f2bf(bflo(k1[e]) * f); KT[(d0 + 8 + 2 * e + 1) * 136 + j] = (bf16)f2bf(bfhi(k1[e]) * f);
          VT[(d0 + 2 * e) * 136 + j] = (bf16)(v0[e] & 0xffffu); VT[(d0 + 2 * e + 1) * 136 + j] = (bf16)(v0[e] >> 16);
          VT[(d0 + 8 + 2 * e) * 136 + j] = (bf16)(v1[e] & 0xffffu); VT[(d0 + 8 + 2 * e + 1) * 136 + j] = (bf16)(v1[e] >> 16); } }
    __syncthreads();
    const int r = F.lane & 15, q = F.lane >> 4;
#pragma unroll
    for (int t2 = 0; t2 < 2; ++t2) { const int t = 2 * F.wave + t2, m0 = (t >> 2) * 16, n0 = (t & 3) * 16; const f32x4 acc = tile16(KT, 136, VT, 136, m0, n0, 128, F.lane);
#pragma unroll
        for (int i = 0; i < 4; ++i) F.L[(size_t)uid * 4096 + (m0 + 4 * q + i) * 64 + n0 + r] = acc[i]; }
    __syncthreads();
}
DI void conv_ln_store(const Ctx& F, const LAS float* dwrow, bf16* dst) {
    const f32x4 a = *(const LAS f32x4*)(dwrow + F.lane * 8), b = *(const LAS f32x4*)(dwrow + F.lane * 8 + 4);
    const float mean = wave_sum((a.x + a.y) + (a.z + a.w) + (b.x + b.y) + (b.z + b.w)) * (1.f / 512);
    const f32x4 da = a - mean, db = b - mean;
    const float var = wave_sum((da.x * da.x + da.y * da.y) + (da.z * da.z + da.w * da.w) + (db.x * db.x + db.y * db.y) + (db.z * db.z + db.w * db.w)) * (1.f / 512);
    const float rstd = 1.0f / sqrtf(var + EPS);
    const f32x4 g0 = *(const f32x4*)(F.cln_g + F.lane * 8), g1 = *(const f32x4*)(F.cln_g + F.lane * 8 + 4), b0 = *(const f32x4*)(F.cln_b + F.lane * 8), b1 = *(const f32x4*)(F.cln_b + F.lane * 8 + 4);
    f32x4 y0 = da * rstd * g0 + b0, y1 = db * rstd * g1 + b1;
#pragma unroll
    for (int e = 0; e < 4; ++e) { y0[e] = y0[e] * sigm(y0[e]); y1[e] = y1[e] * sigm(y1[e]); }
    u32x4 w; w.x = pk2(y0[0], y0[1]); w.y = pk2(y0[2], y0[3]); w.z = pk2(y1[0], y1[1]); w.w = pk2(y1[2], y1[3]);
    *(u32x4*)(dst + F.lane * 8) = w;
}
DI void conv_prompt_unit(const Ctx& F, int cid, const float (&w)[31], float bias) {
    const int b = cid >> 6, t0 = (cid & 63) * 32, ch = F.tid;
    LAS bf16* Us = (LAS bf16*)F.lds; LAS float* DW = (LAS float*)(F.lds + 63488);
    for (int c = F.tid; c < 62 * 64; c += 512) { const int row = c >> 6, cc = c & 63, t = t0 - 30 + row; u32x4 v = {0u, 0u, 0u, 0u};
        if (t >= 0) v = *(const u32x4*)(F.U + (size_t)(b * 2048 + t) * 512 + cc * 8);
        *(LAS u32x4*)(Us + row * 512 + cc * 8) = v; }
    __syncthreads();
#pragma unroll 1
    for (int tb = 0; tb < 4; ++tb) { float acc[8];
#pragma unroll
        for (int o = 0; o < 8; ++o) acc[o] = bias;
#pragma unroll
        for (int jj = 0; jj < 38; ++jj) { const float x = bf2f(Us[(tb * 8 + jj) * 512 + ch]);
#pragma unroll
            for (int o = 0; o < 8; ++o) { const int j = jj - o; if (j >= 0 && j < 31) acc[o] += w[j] * x; } }
#pragma unroll
        for (int o = 0; o < 8; ++o) DW[(tb * 8 + o) * 512 + ch] = acc[o]; }
    if (t0 == 2016) {
#pragma unroll 1
        for (int i = 0; i < 30; ++i) F.out[OUT_CONVP + (size_t)(b * 30 + i) * 512 + ch] = bf2f(Us[(32 + i) * 512 + ch]); }
    __syncthreads();
#pragma unroll 1
    for (int i = 0; i < 4; ++i) { const int tt = F.wave + 8 * i; conv_ln_store(F, DW + tt * 512, F.MIX + (size_t)(b * 2048 + t0 + tt) * 1024); }
    __syncthreads();
}
DI void conv_sample_unit(const Ctx& F, int bs, const float (&w)[31], float bias) {
    const int ch = F.tid; LAS float* DW = (LAS float*)F.lds;
    float ext[34];
#pragma unroll
    for (int i = 0; i < 30; ++i) ext[i] = F.cache[(size_t)(bs * 30 + i) * 512 + ch];
#pragma unroll
    for (int t = 0; t < 4; ++t) ext[30 + t] = bf2f(F.U[(size_t)(MP + bs * 4 + t) * 512 + ch]);
#pragma unroll
    for (int t = 0; t < 4; ++t) { float a = bias;
#pragma unroll
        for (int j = 0; j < 31; ++j) a += w[j] * ext[t + j];
        DW[t * 512 + ch] = a; }
#pragma unroll
    for (int i = 0; i < 30; ++i) F.out[OUT_CONVS + (size_t)(bs * 30 + i) * 512 + ch] = ext[4 + i];
    __syncthreads();
    if (F.wave < 4) conv_ln_store(F, DW + F.wave * 512, F.MIX + (size_t)(MP + bs * 4 + F.wave) * 1024);
    __syncthreads();
}
DI void ret_sample_unit(const Ctx& F, int unit) {
    const int bs = unit >> 3, h = unit & 7, rowb = MP + bs * 4, lane = F.lane; const float lg = LOG2G[h];
    LAS float* QT = (LAS float*)(F.lds + F.wave * 2048); LAS float* KT = QT + 256;
    float qv[4], kv[4], vv[4];
#pragma unroll
    for (int i = 0; i < 4; ++i) { const size_t o = (size_t)(rowb + i) * 512 + h * 64 + lane; qv[i] = bf2f(F.Q[o]); kv[i] = bf2f(F.K[o]); vv[i] = bf2f(F.V[o]); QT[lane * 4 + i] = qv[i]; KT[lane * 4 + i] = kv[i]; }
    LDS_WAIT();
    const float g1 = ex2(lg), g2 = ex2(2.f * lg), g3 = ex2(3.f * lg), g4 = ex2(4.f * lg);
    const float gp[4] = {1.0f, g1, g2, g3};
    float A[4][4];
#pragma unroll
    for (int i = 0; i < 4; ++i)
#pragma unroll
        for (int j = 0; j < 4; ++j) A[i][j] = (j <= i) ? wave_sum(qv[i] * kv[j]) * gp[i - j] : 0.f;
    float cross[4] = {0.f, 0.f, 0.f, 0.f};
    const float* S0 = F.state + (size_t)(bs * 8 + h) * 4096 + lane; float* S1 = F.out + OUT_RETS + (size_t)(bs * 8 + h) * 4096 + lane;
    const float kv0 = g3 * vv[0], kv1 = g2 * vv[1], kv2 = g1 * vv[2], kv3 = vv[3];
#pragma unroll 8
    for (int d = 0; d < 64; ++d) { const float s = S0[d * 64]; const f32x4 qd = *(const LAS f32x4*)(QT + d * 4), kd = *(const LAS f32x4*)(KT + d * 4);
        cross[0] += qd[0] * s; cross[1] += qd[1] * s; cross[2] += qd[2] * s; cross[3] += qd[3] * s;
        S1[d * 64] = g4 * s + kd[0] * kv0 + kd[1] * kv1 + kd[2] * kv2 + kd[3] * kv3; }
    const float gq[4] = {g1, g2, g3, g4};
    const float lng = F.rln_g[h * 64 + lane], lnb = F.rln_b[h * 64 + lane];
#pragma unroll
    for (int i = 0; i < 4; ++i) { float o = gq[i] * cross[i];
#pragma unroll
        for (int j = 0; j < 4; ++j) if (j <= i) o += A[i][j] * vv[j];
        const float mean = wave_sum(o) * (1.f / 64), dl = o - mean, var = wave_sum(dl * dl) * (1.f / 64);
        float y = dl * (1.0f / sqrtf(var + EPS)) * lng + lnb; y *= bf2f(F.Gt[(size_t)(rowb + i) * 512 + h * 64 + lane]);
        F.MIX[(size_t)(rowb + i) * 1024 + 512 + h * 64 + lane] = (bf16)f2bf(y); }
    LDS_WAIT();
}
DI void p3a_phase(const Ctx& F) {
    for (int u = F.bid; u < 1024; u += F.G) ret_local_unit(F, u);
    float w[31];
#pragma unroll
    for (int j = 0; j < 31; ++j) w[j] = F.conv_w[j * 512 + F.tid];
    const float bias = F.conv_b[F.tid];
    for (int c = F.bid; c < 512; c += F.G) conv_prompt_unit(F, c, w, bias);
    const int nconv_wg = F.G >= 256 ? 128 : F.G / 2;
    if (F.bid < nconv_wg) { for (int bs = F.bid; bs < 128; bs += nconv_wg) conv_sample_unit(F, bs, w, bias); }
    else { const int nw = (F.G - nconv_wg) * 8; for (int un = (F.bid - nconv_wg) * 8 + F.wave; un < 1024; un += nw) ret_sample_unit(F, un); }
}
DI void ret_out_unit(const Ctx& F, int uid) {
    const int b = uid >> 7, h = (uid >> 4) & 7, n = uid & 15, row0 = b * 2048 + n * 128; const float lg = LOG2G[h];
    LAS bf16* Qs = (LAS bf16*)F.lds; LAS bf16* Ks = (LAS bf16*)(F.lds + 18432); LAS bf16* Vt = (LAS bf16*)(F.lds + 36864); LAS bf16* PA = (LAS bf16*)(F.lds + 62464);
    { const int j = F.tid >> 2, d0 = (F.tid & 3) * 16; const float f = ex2(lg * (float)(j + 1));
      const size_t go = (size_t)(row0 + j) * 512 + h * 64 + d0;
      const u32x4 q0 = ((const u32x4*)(F.Q + go))[0], q1 = ((const u32x4*)(F.Q + go))[1], k0 = ((const u32x4*)(F.K + go))[0], k1 = ((const u32x4*)(F.K + go))[1], v0 = ((const u32x4*)(F.V + go))[0], v1 = ((const u32x4*)(F.V + go))[1];
      *(LAS u32x4*)(Qs + j * 72 + d0) = q0; *(LAS u32x4*)(Qs + j * 72 + d0 + 8) = q1; *(LAS u32x4*)(Ks + j * 72 + d0) = k0; *(LAS u32x4*)(Ks + j * 72 + d0 + 8) = k1;
      u32x4 a0, a1;
#pragma unroll
      for (int e = 0; e < 4; ++e) { a0[e] = pk2(bflo(q0[e]) * f, bfhi(q0[e]) * f); a1[e] = pk2(bflo(q1[e]) * f, bfhi(q1[e]) * f); }
      *(LAS u32x4*)(PA + j * 200 + 128 + d0) = a0; *(LAS u32x4*)(PA + j * 200 + 128 + d0 + 8) = a1;
#pragma unroll
      for (int e = 0; e < 4; ++e) {
          Vt[(d0 + 2 * e) * 200 + j] = (bf16)(v0[e] & 0xffffu); Vt[(d0 + 2 * e + 1) * 200 + j] = (bf16)(v0[e] >> 16);
          Vt[(d0 + 8 + 2 * e) * 200 + j] = (bf16)(v1[e] & 0xffffu); Vt[(d0 + 8 + 2 * e + 1) * 200 + j] = (bf16)(v1[e] >> 16); } }
    { const int e0 = F.tid * 8, d = F.tid >> 3, dv0 = (F.tid & 7) * 8; const float gC = ex2(lg * 128.f);
      f32x4 s0 = {0.f, 0.f, 0.f, 0.f}, s1 = {0.f, 0.f, 0.f, 0.f}; const float* Lb = F.L + (size_t)(uid - n) * 4096 + e0;
      for (int m = 0; m < n; ++m) { const f32x4 l0 = *(const f32x4*)(Lb + (size_t)m * 4096), l1 = *(const f32x4*)(Lb + (size_t)m * 4096 + 4); s0 = s0 * gC + l0; s1 = s1 * gC + l1; }
#pragma unroll
      for (int e = 0; e < 4; ++e) { Vt[(dv0 + e) * 200 + 128 + d] = (bf16)f2bf(s0[e]); Vt[(dv0 + 4 + e) * 200 + 128 + d] = (bf16)f2bf(s1[e]); }
      if (n == 15) { const f32x4 l0 = *(const f32x4*)(Lb + (size_t)15 * 4096), l1 = *(const f32x4*)(Lb + (size_t)15 * 4096 + 4);
          float* rp = F.out + OUT_RETP + (size_t)(b * 8 + h) * 4096 + e0; *(f32x4*)rp = s0 * gC + l0; *(f32x4*)(rp + 4) = s1 * gC + l1; } }
    __syncthreads();
    const int r = F.lane & 15, q = F.lane >> 4, w = F.wave;
    for (int jt = 0; jt < 8; ++jt) {
        if (jt <= w) { const f32x4 acc = tile16(Qs, 72, Ks, 72, 16 * w, 16 * jt, 64, F.lane);
#pragma unroll
            for (int i = 0; i < 4; ++i) { const int ii = 16 * w + 4 * q + i, jj = 16 * jt + r; const float p = (ii >= jj) ? acc[i] * ex2(lg * (float)(ii - jj)) : 0.f; PA[ii * 200 + jj] = (bf16)f2bf(p); } }
        else {
#pragma unroll
            for (int i = 0; i < 4; ++i) PA[(16 * w + 4 * q + i) * 200 + 16 * jt + r] = (bf16)0; }
    }
    __syncthreads();
    f32x4 o[4];
#pragma unroll
    for (int ct = 0; ct < 4; ++ct) o[ct] = tile16(PA, 200, Vt, 200, 16 * w, 16 * ct, 192, F.lane);
    float lng[4], lnb[4];
#pragma unroll
    for (int ct = 0; ct < 4; ++ct) { lng[ct] = F.rln_g[h * 64 + 16 * ct + r]; lnb[ct] = F.rln_b[h * 64 + 16 * ct + r]; }
#pragma unroll
    for (int i = 0; i < 4; ++i) { const int row = row0 + 16 * w + 4 * q + i;
        const float mean = sum16((o[0][i] + o[1][i]) + (o[2][i] + o[3][i])) * (1.f / 64);
        const float d0 = o[0][i] - mean, d1 = o[1][i] - mean, d2 = o[2][i] - mean, d3 = o[3][i] - mean;
        const float rstd = 1.0f / sqrtf(sum16((d0 * d0 + d1 * d1) + (d2 * d2 + d3 * d3)) * (1.f / 64) + EPS);
        const float dd[4] = {d0, d1, d2, d3};
#pragma unroll
        for (int ct = 0; ct < 4; ++ct) { float y = dd[ct] * rstd * lng[ct] + lnb[ct]; y *= bf2f(F.Gt[(size_t)row * 512 + h * 64 + 16 * ct + r]); F.MIX[(size_t)row * 1024 + 512 + h * 64 + 16 * ct + r] = (bf16)f2bf(y); } }
    __syncthreads();
}

template <int NKS>
DI void small_partials(const Ctx& F, const bf16* A, int lda, int arow0, const bf16* Bt, int ldb, int brow0, int brow1) {
    const int r = F.lane & 15, q = F.lane >> 4, kw0 = F.wave * NKS * 32;
    const bf16* ap = A + (size_t)(arow0 + r) * lda + kw0 + 8 * q; const bf16* b0p = Bt + (size_t)(brow0 + r) * ldb + kw0 + 8 * q; const bf16* b1p = Bt + (size_t)(brow1 + r) * ldb + kw0 + 8 * q;
    f32x4 acc[4][2];
#pragma unroll
    for (int rt = 0; rt < 4; ++rt) { acc[rt][0] = (f32x4){0.f, 0.f, 0.f, 0.f}; acc[rt][1] = (f32x4){0.f, 0.f, 0.f, 0.f}; }
#pragma unroll 1
    for (int kb = 0; kb < NKS; kb += 4) {
        bf16x8 a[4][4], b[4][2];
#pragma unroll
        for (int ks = 0; ks < 4; ++ks) {
#pragma unroll
            for (int rt = 0; rt < 4; ++rt) a[ks][rt] = *(const bf16x8*)(ap + (size_t)rt * 16 * lda + (kb + ks) * 32);
            b[ks][0] = *(const bf16x8*)(b0p + (kb + ks) * 32); b[ks][1] = *(const bf16x8*)(b1p + (kb + ks) * 32); }
#pragma unroll
        for (int ks = 0; ks < 4; ++ks)
#pragma unroll
            for (int rt = 0; rt < 4; ++rt) { acc[rt][0] = __builtin_amdgcn_mfma_f32_16x16x32_bf16(a[ks][rt], b[ks][0], acc[rt][0], 0, 0, 0); acc[rt][1] = __builtin_amdgcn_mfma_f32_16x16x32_bf16(a[ks][rt], b[ks][1], acc[rt][1], 0, 0, 0); }
    }
    LAS float* P = (LAS float*)F.lds + F.wave * 64 * 33;
#pragma unroll
    for (int rt = 0; rt < 4; ++rt)
#pragma unroll
        for (int ct = 0; ct < 2; ++ct)
#pragma unroll
            for (int i = 0; i < 4; ++i) P[(16 * rt + 4 * q + i) * 33 + 16 * ct + r] = acc[rt][ct][i];
    __syncthreads();
}
DI float red_sum(const Ctx& F, int row, int col) { const LAS float* P = (const LAS float*)F.lds + row * 33 + col; float s = 0.f;
#pragma unroll
    for (int w = 0; w < 8; ++w) s += P[w * 64 * 33];
    return s; }
DI void small_in_unit(const Ctx& F, int id) {
    const int ru = id & 7, cu = id >> 3, pn = cu >> 3, o = 16 * (cu & 7);
    small_partials<4>(F, F.XN, D, MP + 64 * ru, F.Wt_in, D, 256 * pn + o, 256 * pn + 128 + o);
    const int row = F.tid >> 3, c = (F.tid & 7) * 2, r = MP + 64 * ru + row;
    const float a0 = red_sum(F, row, c), a1 = red_sum(F, row, c + 1), b0 = red_sum(F, row, 16 + c), b1 = red_sum(F, row, 16 + c + 1);
    if (pn < 4) { *(unsigned*)(F.U + (size_t)r * 512 + 128 * pn + o + c) = pk2(a0 * sigm(b0), a1 * sigm(b1)); }
    else if (pn < 8) { const bool isq = pn < 6; bf16* base = isq ? F.Q : F.K; const float sc = isq ? 0.125f : 1.0f; const int d = (o & 31) + c, head = 4 * ((pn - 4) & 1) + (o >> 5), pi = pg8::posidx_of_row(r);
        const float c0 = F.cosT[pi * 32 + d], c1 = F.cosT[pi * 32 + d + 1], s0 = F.sinT[pi * 32 + d], s1 = F.sinT[pi * 32 + d + 1];
        *(unsigned*)(base + (size_t)r * 512 + head * 64 + d) = pk2((a0 * c0 - b0 * s0) * sc, (a1 * c1 - b1 * s1) * sc);
        *(unsigned*)(base + (size_t)r * 512 + head * 64 + 32 + d) = pk2((a0 * s0 + b0 * c0) * sc, (a1 * s1 + b1 * c1) * sc); }
    else { const bool isg = pn >= 10; bf16* base = isg ? F.Gt : F.V; const int col = 256 * ((pn - 8) & 1) + o + c;
        float v0 = a0, v1 = a1, w0 = b0, w1 = b1; if (isg) { v0 *= sigm(v0); v1 *= sigm(v1); w0 *= sigm(w0); w1 *= sigm(w1); }
        *(unsigned*)(base + (size_t)r * 512 + col) = pk2(v0, v1); *(unsigned*)(base + (size_t)r * 512 + col + 128) = pk2(w0, w1); }
    __syncthreads();
}
template <int NKS>
DI void small_res_unit(const Ctx& F, int id, const bf16* A, int lda, const bf16* Bt, const float* xs, const float* gate) {
    const int ru = id & 7, cu = id >> 3;
    small_partials<NKS>(F, A, lda, MP + 64 * ru, Bt, lda, 32 * cu, 32 * cu + 16);
    const int row = F.tid >> 3, c = (F.tid & 7) * 2, rs = 64 * ru + row, r = MP + rs; const float* gr = gate + (size_t)pg8::bidx_of_row(r) * NMOD;
#pragma unroll
    for (int t = 0; t < 2; ++t) { const int col = 32 * cu + 16 * t + c; const float v0 = red_sum(F, row, 16 * t + c), v1 = red_sum(F, row, 16 * t + c + 1);
        const float x0 = xs[(size_t)rs * D + col], x1 = xs[(size_t)rs * D + col + 1];
        F.out[(size_t)r * D + col] = x0 + gr[col] * v0; F.out[(size_t)r * D + col + 1] = x1 + gr[col + 1] * v1; }
    __syncthreads();
}
DI void small_ff1_unit(const Ctx& F, int id) {
    const int ru = id & 7, cu = id >> 3;
    small_partials<4>(F, F.XN, D, MP + 64 * ru, F.Wt_1, D, 32 * cu, 32 * cu + 16);
    const int row = F.tid >> 3, c = (F.tid & 7) * 2, r = MP + 64 * ru + row;
#pragma unroll
    for (int t = 0; t < 2; ++t) { const float v0 = fmaxf(red_sum(F, row, 16 * t + c), 0.f), v1 = fmaxf(red_sum(F, row, 16 * t + c + 1), 0.f);
        *(unsigned*)(F.H + (size_t)r * FF + 32 * cu + 16 * t + c) = pk2(v0 * v0, v1 * v1); }
    __syncthreads();
}

#define XB_TMO      128
#define XB_XCNT(j)  (256  + 64 * (j))
#define XB_XSUB(j)  (1280 + 64 * (j))
#define XB_XGEN(j)  (2304 + 64 * (j))
#define XB_TOP      3328
#define XB_TOPGEN   3392
#define XCD_BAR_WORDS 3456
#define XB_SPIN_CAP (1u << 18)

__device__ __forceinline__ unsigned xb_ld(unsigned* p)              { return __hip_atomic_load(p, __ATOMIC_RELAXED, __HIP_MEMORY_SCOPE_AGENT); }
__device__ __forceinline__ unsigned xb_add(unsigned* p, unsigned v) { return __hip_atomic_fetch_add(p, v, __ATOMIC_RELAXED, __HIP_MEMORY_SCOPE_AGENT); }
__device__ __forceinline__ unsigned xb_xcc_id() { return (unsigned)__builtin_amdgcn_s_getreg((3 << 11) | 20) & 0xFu; }
#define XB_SPIN(cond, bar) do { unsigned _sp = 0; while (cond) { __builtin_amdgcn_s_sleep(1); \
    if ((++_sp & 255u) == 0u) { if (xb_ld(&(bar)[XB_TMO])) break; if (_sp > XB_SPIN_CAP) { atomicAdd(&(bar)[XB_TMO], 1u); break; } } } } while (0)

struct XcdBarrier {
    unsigned* bar; unsigned x;
    volatile LAS unsigned* st;
};

__device__ __forceinline__ XcdBarrier xcd_barrier_post(unsigned* bar, volatile LAS unsigned* st) {
    XcdBarrier b; b.bar = bar; b.x = xb_xcc_id(); b.st = st;
    if (threadIdx.x == 0) (void)xb_add(&bar[XB_XCNT(b.x)], 1u);
    return b;
}
__device__ __forceinline__ void xcd_barrier_complete(unsigned* bar, unsigned x, unsigned& nloc, unsigned& nx) {
    const unsigned G = gridDim.x * gridDim.y * gridDim.z;
    unsigned sum, cnt, mine, sp = 0u;
    for (;;) {
        sum = 0u; cnt = 0u; mine = 0u;
#pragma unroll
        for (unsigned j = 0; j < 16; ++j) { const unsigned c = xb_ld(&bar[XB_XCNT(j)]); sum += c; cnt += (c > 0u) ? 1u : 0u; mine = (j == x) ? c : mine; }
        if (sum == G) break;
        __builtin_amdgcn_s_sleep(1);
        if ((++sp & 255u) == 0u) { if (xb_ld(&bar[XB_TMO])) break; if (sp > XB_SPIN_CAP) { atomicAdd(&bar[XB_TMO], 1u); break; } }
    }
    nloc = mine > 0u ? mine : 1u; nx = cnt > 0u ? cnt : 1u;
}

__device__ __forceinline__ void xcd_barrier(const XcdBarrier& b) {
    asm volatile("s_waitcnt vmcnt(0)" ::: "memory");
    __syncthreads();
    if (threadIdx.x == 0) {
        unsigned* bar = b.bar;
        __builtin_amdgcn_s_waitcnt(0);
        unsigned nloc = b.st[0], nx = b.st[1];
        if (nloc == 0u) { xcd_barrier_complete(bar, b.x, nloc, nx); b.st[0] = nloc; b.st[1] = nx; }
        const unsigned old = xb_add(&bar[XB_XSUB(b.x)], 1u);
        const unsigned gen = old / nloc;
        if (old + 1u == (gen + 1u) * nloc) {
            __builtin_amdgcn_fence(__ATOMIC_RELEASE, "agent");
            asm volatile("s_waitcnt vmcnt(0)" ::: "memory");
            const unsigned og = xb_add(&bar[XB_TOP], 1u);
            const unsigned tg = og / nx;
            if (og + 1u == (tg + 1u) * nx) xb_add(&bar[XB_TOPGEN], 1u);
            else XB_SPIN(xb_ld(&bar[XB_TOPGEN]) == tg, bar);
            __builtin_amdgcn_fence(__ATOMIC_ACQUIRE, "agent");
            xb_add(&bar[XB_XGEN(b.x)], 1u);
            asm volatile("s_waitcnt vmcnt(0)" ::: "memory");
        } else {
            XB_SPIN(xb_ld(&bar[XB_XGEN(b.x)]) == gen, bar);
            __builtin_amdgcn_fence(__ATOMIC_ACQUIRE, "agent");
            asm volatile("s_waitcnt vmcnt(0)" ::: "memory");
        }
    }
    __syncthreads();
}

__global__ void __launch_bounds__(512, 2) fwd_kernel(Args a) {
    extern __shared__ __attribute__((aligned(16))) unsigned char lds_raw[];
    Ctx F;
    F.lds = (LAS unsigned char*)lds_raw; F.tid = threadIdx.x; F.lane = F.tid & 63; F.wave = __builtin_amdgcn_readfirstlane(F.tid >> 6); F.G = gridDim.x; F.bid = blockIdx.x;
    F.xp = a.in[0]; F.xs = a.in[1]; F.cache = a.in[2]; F.state = a.in[3]; F.cp = a.in[4]; F.cs = a.in[5]; F.w_ada = a.in[6]; F.b_ada = a.in[7]; F.g_mix = a.in[8]; F.w_in = a.in[9]; F.conv_w = a.in[10]; F.conv_b = a.in[11];
    F.cln_g = a.in[12]; F.cln_b = a.in[13]; F.rln_g = a.in[14]; F.rln_b = a.in[15]; F.w_out = a.in[16]; F.g_ffn = a.in[17]; F.w_ff1 = a.in[18]; F.w_ff2 = a.in[19]; F.g_fin = a.in[20];
    F.out = a.out; unsigned char* ws = a.ws;
    F.Wt_in = (bf16*)(ws + WS_WIN); F.Wt_out = (bf16*)(ws + WS_WOUT); F.Wt_1 = (bf16*)(ws + WS_W1); F.Wt_2 = (bf16*)(ws + WS_W2); F.MOD = (float*)(ws + WS_MOD); F.cosT = (float*)(ws + WS_COS); F.sinT = (float*)(ws + WS_SIN);
    F.XN = (bf16*)(ws + WS_XN); F.U = (bf16*)(ws + WS_U); F.Q = (bf16*)(ws + WS_Q); F.K = (bf16*)(ws + WS_K); F.V = (bf16*)(ws + WS_V); F.Gt = (bf16*)(ws + WS_G); F.MIX = (bf16*)(ws + WS_MIX); F.L = (float*)(ws + WS_L); F.H = (bf16*)(ws + WS_H);
    if (F.tid < 8) ((volatile LAS unsigned*)(F.lds + 131072 + 64))[F.tid] = 0u;
    __syncthreads();
    XcdBarrier bar = xcd_barrier_post((unsigned*)ws, (volatile LAS unsigned*)(F.lds + 131072 + 64));
    const int lo = a.ph_lo, hi = a.ph_hi;
    if (hi > 1000) cg::this_grid().sync();
#define IN(k) (lo <= (k) && (k) < hi)
#define SEAM(k) do { if (IN(k) && IN((k) + 1)) xcd_barrier(bar); } while (0)
#ifndef PROBE_MASK
#define PROBE_MASK 0
#endif
#define REP(k) for (int rep_ = 0; rep_ < (((PROBE_MASK >> (k)) & 1) ? 2 : 1); ++rep_, (rep_ < (((PROBE_MASK >> (k)) & 1) ? 2 : 1) ? xcd_barrier(bar) : (void)0))
    if (IN(0)) REP(0) { p0_prologue(F); } SEAM(0);
#ifdef PROBE_SYNCS
    for (int i_ = 0; i_ < PROBE_SYNCS; ++i_) xcd_barrier(bar);
#endif
    if (IN(1)) REP(1) { p1_tables(F); modnorm_phase(F, F.xp, F.xs, F.g_mix, 0, 1024); } SEAM(1);
    if (IN(2)) REP(2) { pg8::Gemm g{F.XN, F.Wt_in, MP, DIN, D}; pg8::StaticOrder S; S.init(MP, DIN, F.G, F.bid); pg8::EpiIn E{F.U, F.Q, F.K, F.V, F.Gt, F.cosT, F.sinT};
        pg8::gemm_phase<pg8::EpiIn, pg8::StaticOrder, true, true>(F.lds, g, S, E);
        for (int id = F.bid; id < 768; id += F.G) small_in_unit(F, id); } SEAM(2);
    if (IN(3)) REP(3) { p3a_phase(F); } SEAM(3);
    if (IN(4)) REP(4) { for (int u = F.bid; u < 1024; u += F.G) ret_out_unit(F, u); } SEAM(4);
    if (IN(5)) REP(5) { pg8::Gemm g{F.MIX, F.Wt_out, MP, D, D}; pg8::StaticOrder S; S.init(MP, D, F.G, F.bid); pg8::EpiRes E{F.xp, F.xs, F.out, F.MOD + 2048};
        pg8::gemm_phase<pg8::EpiRes, pg8::StaticOrder, true, true>(F.lds, g, S, E);
        for (int id = F.bid; id < 256; id += F.G) small_res_unit<4>(F, id, F.MIX, D, F.Wt_out, F.xs, F.MOD + 2048); } SEAM(5);
    if (IN(6)) REP(6) { modnorm_phase(F, F.out, F.out + (size_t)MP * D, F.g_ffn, 3072, 4096); } SEAM(6);
    if (IN(7)) REP(7) { pg8::Gemm g{F.XN, F.Wt_1, MP, FF, D}; pg8::StaticOrder S; S.init(MP, FF, F.G, F.bid); pg8::EpiFF1 E{F.H};
        pg8::gemm_phase<pg8::EpiFF1, pg8::StaticOrder, true, true>(F.lds, g, S, E);
        for (int id = F.bid; id < 1024; id += F.G) small_ff1_unit(F, id); } SEAM(7);
    if (IN(8)) REP(8) { pg8::Gemm g{F.H, F.Wt_2, MP, D, FF}; pg8::StaticOrder S; S.init(MP, D, F.G, F.bid); pg8::EpiRes E{F.out, F.out + (size_t)MP * D, F.out, F.MOD + 5120};
        pg8::gemm_phase<pg8::EpiRes, pg8::StaticOrder, true, true>(F.lds, g, S, E);
        for (int id = F.bid; id < 256; id += F.G) small_res_unit<16>(F, id, F.H, FF, F.Wt_2, F.out + (size_t)MP * D, F.MOD + 5120); } SEAM(8);
    if (IN(9)) REP(9) { final_norm_phase(F); }
#undef IN
#undef SEAM
}

extern "C" void kernel_launch(void* const* d_in, const int* in_sizes, int n_in, void* d_out, int out_size, void* d_ws, size_t ws_size, hipStream_t stream) {
    static int grid = 0;
    if (grid == 0) {
        if (n_in != 21 || (size_t)out_size != OUT_END || ws_size < WS_END) { fprintf(stderr, "kernel_launch: unexpected shapes: n_in %d out %d ws %zu\n", n_in, out_size, ws_size); grid = -1; return; }
        int dev = 0, cus = 0, per_cu = 0;
        (void)hipGetDevice(&dev); (void)hipDeviceGetAttribute(&cus, hipDeviceAttributeMultiprocessorCount, dev);
        if (hipFuncSetAttribute((const void*)fwd_kernel, hipFuncAttributeMaxDynamicSharedMemorySize, LDS_BYTES) != hipSuccess) { fprintf(stderr, "kernel_launch: hipFuncSetAttribute failed\n"); grid = -1; return; }
        if (hipOccupancyMaxActiveBlocksPerMultiprocessor(&per_cu, (const void*)fwd_kernel, 512, LDS_BYTES) != hipSuccess || per_cu < 1) { fprintf(stderr, "kernel_launch: occupancy query says %d\n", per_cu); per_cu = 1; }
        (void)hipGetLastError();
        grid = cus * per_cu;
    }
    if (grid < 0) return;
    if (hipMemsetAsync(d_ws, 0, 16384, stream) != hipSuccess) { fprintf(stderr, "kernel_launch: hipMemsetAsync failed\n"); return; }
    Args a{};
    for (int i = 0; i < 21; ++i) a.in[i] = (const float*)d_in[i];
    a.out = (float*)d_out; a.ws = (unsigned char*)d_ws;
#if MK_ONE_LAUNCH
    a.ph_lo = 0; a.ph_hi = NPHASE;
    void* args[] = {&a};
    hipError_t e = hipLaunchCooperativeKernel((const void*)fwd_kernel, dim3(grid), dim3(512), args, LDS_BYTES, stream);
    if (e != hipSuccess) fprintf(stderr, "cooperative launch failed: %s (grid %d)\n", hipGetErrorString(e), grid);
#else
    for (int p = 0; p < NPHASE; ++p) { a.ph_lo = p; a.ph_hi = p + 1; hipLaunchKernelGGL(fwd_kernel, dim3(grid), dim3(512), LDS_BYTES, stream, a); }
#endif
}
```

```cpp
#include <hip/hip_runtime.h>
#include <hip/hip_cooperative_groups.h>
#include <cstdio>
#include <cstdint>
namespace pg8 {
#define PG8_LAS __attribute__((address_space(3)))
typedef unsigned short bf16_t;
typedef short bf16x8 __attribute__((ext_vector_type(8)));
typedef float f32x4 __attribute__((ext_vector_type(4)));
typedef unsigned u32x4 __attribute__((ext_vector_type(4)));
typedef unsigned u32x2 __attribute__((ext_vector_type(2)));
constexpr int BM = 256, BK = 64, HALF = 128, HTB = HALF * BK * 2  , STAGE_BYTES = 8 * HTB, NXCD = 8, WGM = 8;

__host__ __device__ __forceinline__ int lds_byte(int r, int c) { const int st = (r >> 4) * 2 + (c >> 5), rr = r & 15, cc = c & 31, ob = rr * 64 + cc * 2; return st * 1024 + (ob ^ (((ob >> 9) & 1) << 5)); }
__host__ __device__ __forceinline__ void stage_rc(int b, int& R, int& C) { const int st = b / 1024, sb = b % 1024, swz = sb ^ (((sb >> 9) & 1) << 5); R = (st >> 1) * 16 + swz / 64; C = (st & 1) * 32 + (swz % 64) / 2; }
__host__ __device__ __forceinline__ int perm32(int rho) { const int n = rho >> 4, i = rho & 15; return 8 * (i >> 2) + 4 * n + (i & 3); }

struct Unit { int pm, pn; };
struct Gemm { const bf16_t* A; const bf16_t* Bt; int M, N, K; };

struct StaticOrder {
    int nM, nN, nwg, G, c;
    __host__ __device__ void init(int M, int N, int G_, int c_) { nM = M / BM; nN = N / BM; nwg = nM * nN; G = G_; c = c_; }
    __host__ __device__ bool next(int i, Unit& u) const {
        const long L = (long)i * G + c; if (L >= nwg) return false;
        int wgid = (int)L; { const int q = nwg / NXCD, r = nwg % NXCD, xcd = wgid % NXCD, off = wgid / NXCD; wgid = (xcd < r ? xcd * (q + 1) : r * (q + 1) + (xcd - r) * q) + off; }
        const int nig = WGM * nN, gid = wgid / nig, fm = gid * WGM, gsz = (nM - fm) < WGM ? (nM - fm) : WGM;
        u.pm = fm + ((wgid % nig) % gsz); u.pn = (wgid % nig) / gsz; return true;
    }
    __device__ __forceinline__ void a_ready(const Unit&) const {}
    __device__ __forceinline__ void done(const Unit&) const {}
};

__device__ __forceinline__ unsigned cvt_pk_bf16(float lo, float hi) { unsigned r; asm volatile("v_cvt_pk_bf16_f32 %0, %1, %2" : "=v"(r) : "v"(lo), "v"(hi)); return r; }
typedef float f32x2 __attribute__((ext_vector_type(2)));
__device__ __forceinline__ float sigmoid_f(float x) { return __builtin_amdgcn_rcpf(1.0f + __expf(-x)); }
__device__ __forceinline__ int bidx_of_row(int r) { return r < 16384 ? (r >> 11) : 8 + ((r - 16384) >> 2); }
__device__ __forceinline__ int posidx_of_row(int r) { return r < 16384 ? (r & 2047) : 2048 + ((r - 16384) & 3); }

struct EpiIn {
    static constexpr bool PERM = true, AFTER_DRAIN = false;
    bf16_t *U, *Q, *Kb, *V, *G; const float* cosT; const float* sinT;
    __device__ __forceinline__ void operator()(const f32x4 (&acc)[2][2][4][2], const Unit& u, int wr, int wc, int fr, int fq) const {
        const int row0 = u.pm * BM + wr * 64 + fr; const int o0 = wc * 32 + 8 * fq; const int pn = u.pn;
        if (pn < 4) {
#pragma unroll
            for (int ai = 0; ai < 2; ++ai)
#pragma unroll
                for (int m = 0; m < 4; ++m) { const int r = row0 + ai * HALF + m * 16;
                    const f32x4 a0 = acc[ai][0][m][0], a1 = acc[ai][0][m][1], b0 = acc[ai][1][m][0], b1 = acc[ai][1][m][1];
                    u32x4 w; w.x = cvt_pk_bf16(a0[0] * sigmoid_f(b0[0]), a0[1] * sigmoid_f(b0[1])); w.y = cvt_pk_bf16(a0[2] * sigmoid_f(b0[2]), a0[3] * sigmoid_f(b0[3]));
                    w.z = cvt_pk_bf16(a1[0] * sigmoid_f(b1[0]), a1[1] * sigmoid_f(b1[1])); w.w = cvt_pk_bf16(a1[2] * sigmoid_f(b1[2]), a1[3] * sigmoid_f(b1[3]));
                    *(u32x4*)(U + (size_t)r * 512 + 128 * pn + o0) = w; }
        } else if (pn < 8) {
            const bool isq = pn < 6; bf16_t* base = isq ? Q : Kb; const float sc = isq ? 0.125f : 1.0f;
            const int colb = (4 * ((pn - 4) & 1) + wc) * 64 + 8 * fq;
#pragma unroll
            for (int ai = 0; ai < 2; ++ai)
#pragma unroll
                for (int m = 0; m < 4; ++m) { const int r = row0 + ai * HALF + m * 16; const int pi = posidx_of_row(r);
                    const f32x4 c0 = *(const f32x4*)(cosT + pi * 32 + 8 * fq), c1 = *(const f32x4*)(cosT + pi * 32 + 8 * fq + 4);
                    const f32x4 s0 = *(const f32x4*)(sinT + pi * 32 + 8 * fq), s1 = *(const f32x4*)(sinT + pi * 32 + 8 * fq + 4);
                    const f32x4 x10 = acc[ai][0][m][0], x11 = acc[ai][0][m][1], x20 = acc[ai][1][m][0], x21 = acc[ai][1][m][1];
                    const f32x4 p0 = (x10 * c0 - x20 * s0) * sc, p1 = (x11 * c1 - x21 * s1) * sc, q0 = (x10 * s0 + x20 * c0) * sc, q1 = (x11 * s1 + x21 * c1) * sc;
                    u32x4 w; w.x = cvt_pk_bf16(p0[0], p0[1]); w.y = cvt_pk_bf16(p0[2], p0[3]); w.z = cvt_pk_bf16(p1[0], p1[1]); w.w = cvt_pk_bf16(p1[2], p1[3]);
                    *(u32x4*)(base + (size_t)r * 512 + colb) = w;
                    w.x = cvt_pk_bf16(q0[0], q0[1]); w.y = cvt_pk_bf16(q0[2], q0[3]); w.z = cvt_pk_bf16(q1[0], q1[1]); w.w = cvt_pk_bf16(q1[2], q1[3]);
                    *(u32x4*)(base + (size_t)r * 512 + colb + 32) = w; }
        } else {
            const bool isg = pn >= 10; bf16_t* base = isg ? G : V; const int colb = 256 * ((pn - 8) & 1) + o0;
#pragma unroll
            for (int ai = 0; ai < 2; ++ai)
#pragma unroll
                for (int m = 0; m < 4; ++m) { const int r = row0 + ai * HALF + m * 16;
#pragma unroll
                    for (int bj = 0; bj < 2; ++bj) { f32x4 v0 = acc[ai][bj][m][0], v1 = acc[ai][bj][m][1];
                        if (isg) {
#pragma unroll
                            for (int e = 0; e < 4; ++e) { v0[e] = v0[e] * sigmoid_f(v0[e]); v1[e] = v1[e] * sigmoid_f(v1[e]); } }
                        u32x4 w; w.x = cvt_pk_bf16(v0[0], v0[1]); w.y = cvt_pk_bf16(v0[2], v0[3]); w.z = cvt_pk_bf16(v1[0], v1[1]); w.w = cvt_pk_bf16(v1[2], v1[3]);
                        *(u32x4*)(base + (size_t)r * 512 + colb + bj * HALF) = w; } }
        }
    }
};

struct EpiRes {
    static constexpr bool PERM = true, AFTER_DRAIN = false;
    const float* xp; const float* xs; float* out; const float* gate;
    __device__ __forceinline__ void operator()(const f32x4 (&acc)[2][2][4][2], const Unit& u, int wr, int wc, int fr, int fq) const {
        const int col0 = u.pn * BM + wc * 32 + 8 * fq;
#pragma unroll
        for (int ai = 0; ai < 2; ++ai)
#pragma unroll
            for (int m = 0; m < 4; ++m) { const int r = u.pm * BM + ai * HALF + wr * 64 + m * 16 + fr;
                const float* xr = r < 16384 ? xp + (size_t)r * 1024 : xs + (size_t)(r - 16384) * 1024; const float* gr = gate + (size_t)bidx_of_row(r) * 6144;
#pragma unroll
                for (int bj = 0; bj < 2; ++bj)
#pragma unroll
                    for (int n = 0; n < 2; ++n) { const int c = col0 + bj * HALF + n * 4;
                        const f32x4 xv = *(const f32x4*)(xr + c), gv = *(const f32x4*)(gr + c);
                        *(f32x4*)(out + (size_t)r * 1024 + c) = xv + gv * acc[ai][bj][m][n]; } }
    }
};

struct EpiOutZ {
    static constexpr bool PERM = true, AFTER_DRAIN = false;
    const float* xp; float* out; const float* mod; const float* gffn; bf16_t* Z; float* ssq;
    __device__ __forceinline__ void operator()(const f32x4 (&acc)[2][2][4][2], const Unit& u, int wr, int wc, int fr, int fq) const {
        const int col0 = u.pn * BM + wc * 32 + 8 * fq; const float* mr = mod + (size_t)(u.pm >> 3) * 6144;
        f32x4 gt[2][2], gs[2][2];
#pragma unroll
        for (int bj = 0; bj < 2; ++bj)
#pragma unroll
            for (int n = 0; n < 2; ++n) { const int c = col0 + bj * HALF + n * 4; gt[bj][n] = *(const f32x4*)(mr + 2048 + c); gs[bj][n] = *(const f32x4*)(gffn + c) * (*(const f32x4*)(mr + 4096 + c) + 1.0f); }
#pragma unroll
        for (int ai = 0; ai < 2; ++ai)
#pragma unroll
            for (int m = 0; m < 4; ++m) { const int r = u.pm * BM + ai * HALF + wr * 64 + m * 16 + fr; float q = 0.f;
#pragma unroll
                for (int bj = 0; bj < 2; ++bj) { const size_t o = (size_t)r * 1024 + col0 + bj * HALF;
                    const f32x4 x10 = *(const f32x4*)(xp + o) + gt[bj][0] * acc[ai][bj][m][0], x11 = *(const f32x4*)(xp + o + 4) + gt[bj][1] * acc[ai][bj][m][1];
                    *(f32x4*)(out + o) = x10; *(f32x4*)(out + o + 4) = x11;
                    q += ((x10[0] * x10[0] + x10[1] * x10[1]) + (x10[2] * x10[2] + x10[3] * x10[3])) + ((x11[0] * x11[0] + x11[1] * x11[1]) + (x11[2] * x11[2] + x11[3] * x11[3]));
                    const f32x4 z0 = x10 * gs[bj][0], z1 = x11 * gs[bj][1]; u32x4 w; w.x = cvt_pk_bf16(z0[0], z0[1]); w.y = cvt_pk_bf16(z0[2], z0[3]); w.z = cvt_pk_bf16(z1[0], z1[1]); w.w = cvt_pk_bf16(z1[2], z1[3]);
                    *(u32x4*)(Z + o) = w; }
                q += __shfl_xor(q, 16); q += __shfl_xor(q, 32);
                if (fq == 0) ssq[(size_t)r * 16 + u.pn * 4 + wc] = q; }
    }
};

struct EpiFF1 {
    static constexpr bool PERM = true, AFTER_DRAIN = false;
    bf16_t* H; const float* ssq; const float* bias2;
    __device__ __forceinline__ void operator()(const f32x4 (&acc)[2][2][4][2], const Unit& u, int wr, int wc, int fr, int fq) const {
        const int row0 = u.pm * BM + wr * 64 + fr; const int col0 = u.pn * BM + wc * 32 + 8 * fq; const float* br = bias2 + (size_t)(u.pm >> 3) * 4096 + col0;
        f32x4 bv[2][2];
#pragma unroll
        for (int bj = 0; bj < 2; ++bj) { bv[bj][0] = *(const f32x4*)(br + bj * HALF); bv[bj][1] = *(const f32x4*)(br + bj * HALF + 4); }
#pragma unroll
        for (int ai = 0; ai < 2; ++ai)
#pragma unroll
            for (int m = 0; m < 4; ++m) { const int r = row0 + ai * HALF + m * 16; bf16_t* rowp = H + (size_t)r * 4096 + col0;
                const f32x4* sp = (const f32x4*)(ssq + (size_t)r * 16); const f32x4 s0 = sp[0], s1 = sp[1], s2 = sp[2], s3 = sp[3];
                const float tot = ((s0[0] + s0[1]) + (s0[2] + s0[3])) + ((s1[0] + s1[1]) + (s1[2] + s1[3])) + ((s2[0] + s2[1]) + (s2[2] + s2[3])) + ((s3[0] + s3[1]) + (s3[2] + s3[3]));
                const float rstd = 1.0f / sqrtf(tot * (1.0f / 1024.0f) + 1e-6f);
#pragma unroll
                for (int bj = 0; bj < 2; ++bj) { f32x4 v0 = acc[ai][bj][m][0] * rstd + bv[bj][0], v1 = acc[ai][bj][m][1] * rstd + bv[bj][1];
#pragma unroll
                    for (int e = 0; e < 4; ++e) { const float a = fmaxf(v0[e], 0.f), b = fmaxf(v1[e], 0.f); v0[e] = a * a; v1[e] = b * b; }
                    u32x4 w; w.x = cvt_pk_bf16(v0[0], v0[1]); w.y = cvt_pk_bf16(v0[2], v0[3]); w.z = cvt_pk_bf16(v1[0], v1[1]); w.w = cvt_pk_bf16(v1[2], v1[3]);
                    *(u32x4*)(rowp + bj * HALF) = w; } }
    }
};

template <class Epi, class Sched, bool ALIGN_EPI = false, bool SP2 = false>
__device__ __forceinline__ void gemm_phase(PG8_LAS unsigned char* lds, const Gemm g, const Sched& S, const Epi& E) {
    const int tid = threadIdx.x, wid = __builtin_amdgcn_readfirstlane(tid >> 6), lane = tid & 63, wr = wid >> 2, wc = wid & 3, fr = lane & 15, fq = lane >> 4;
    const int K = g.K, nt = K / BK;
    unsigned voffA[2], voffB[2];
#pragma unroll
    for (int i = 0; i < 2; ++i) { int R, C; stage_rc(tid * 16 + i * 8192, R, C); const int Rb = Epi::PERM ? ((R & ~31) + perm32(R & 31)) : R;
        voffA[i] = (unsigned)(R * K + C) * 2u; voffB[i] = (unsigned)(Rb * K + C) * 2u; }
    const size_t kstep = (size_t)(BK * 2);
    const size_t hstep = (size_t)HALF * K * 2;
    const size_t tstep = 2 * hstep;
    const unsigned ldsw = (unsigned)wid * 1024u;
    const int aoff = lds_byte(wr * 64 + fr, fq * 8), boff = lds_byte(wc * 32 + fr, fq * 8);
#define PG8_SA(b, h) (((b) * 2 + (h)) * HTB)
#define PG8_SB(b, h) ((4 + (b) * 2 + (h)) * HTB)
#define PG8_STAGE(bufoff, gbase, voff) do { _Pragma("unroll") for (int _i = 0; _i < 2; ++_i) \
        __builtin_amdgcn_global_load_lds((const unsigned*)((const char*)(gbase) + (voff)[_i]), (PG8_LAS unsigned*)(lds + (bufoff) + ldsw + _i * 8192), 16, 0, 0); } while (0)
#define PG8_LDA(dst, b, h) do { _Pragma("unroll") for (int m = 0; m < 4; ++m) _Pragma("unroll") for (int k = 0; k < 2; ++k) dst[m][k] = *(const PG8_LAS bf16x8*)(lds + PG8_SA(b, h) + aoff + m * 2048 + k * 1024); } while (0)
#define PG8_LDB(dst, b, h) do { _Pragma("unroll") for (int n = 0; n < 2; ++n) _Pragma("unroll") for (int k = 0; k < 2; ++k) dst[n][k] = *(const PG8_LAS bf16x8*)(lds + PG8_SB(b, h) + boff + n * 2048 + k * 1024); } while (0)
#define PG8_MMA(ai, bj, At, Bt) do { __builtin_amdgcn_s_setprio(1); _Pragma("unroll") for (int m = 0; m < 4; ++m) _Pragma("unroll") for (int n = 0; n < 2; ++n) _Pragma("unroll") for (int k = 0; k < 2; ++k) \
        acc[ai][bj][m][n] = __builtin_amdgcn_mfma_f32_16x16x32_bf16(Bt[n][k], At[m][k], acc[ai][bj][m][n], 0, 0, 0); __builtin_amdgcn_s_setprio(0); } while (0)
#define PG8_WAIT_V(n) asm volatile("s_waitcnt vmcnt(" #n ")" ::: "memory")
#define PG8_WAIT_L(n) asm volatile("s_waitcnt lgkmcnt(" #n ")" ::: "memory")
#define PG8_BAR __builtin_amdgcn_s_barrier()
#define PG8_SCHED __builtin_amdgcn_sched_barrier(0)
    Unit cur, nxt; int ui = 0;
    if (!S.next(0, cur)) return;
    f32x4 acc[2][2][4][2];
#pragma unroll
    for (int a = 0; a < 2; ++a)
#pragma unroll
        for (int b = 0; b < 2; ++b)
#pragma unroll
            for (int m = 0; m < 4; ++m)
#pragma unroll
                for (int n = 0; n < 2; ++n) acc[a][b][m][n] = (f32x4){0.f, 0.f, 0.f, 0.f};
    bf16x8 At[4][2], B0[2][2], B1[2][2];
    const char* cA = (const char*)g.A + (size_t)cur.pm * tstep; const char* cB = (const char*)g.Bt + (size_t)cur.pn * tstep;
    S.a_ready(cur);
    if constexpr (SP2) {
        PG8_STAGE(PG8_SB(0, 0), cB, voffB); PG8_STAGE(PG8_SB(0, 1), cB + hstep, voffB); PG8_STAGE(PG8_SA(0, 0), cA, voffA); PG8_STAGE(PG8_SA(0, 1), cA + hstep, voffA);
        if (wr == 1) PG8_BAR;
        PG8_WAIT_V(2); PG8_BAR;
        PG8_STAGE(PG8_SB(1, 0), cB + kstep, voffB); PG8_STAGE(PG8_SA(1, 0), cA + kstep, voffA); PG8_STAGE(PG8_SB(1, 1), cB + hstep + kstep, voffB);
        PG8_WAIT_V(6); PG8_BAR;
    } else {
        PG8_STAGE(PG8_SB(0, 0), cB, voffB); PG8_STAGE(PG8_SA(0, 0), cA, voffA); PG8_STAGE(PG8_SB(0, 1), cB + hstep, voffB); PG8_STAGE(PG8_SA(0, 1), cA + hstep, voffA);
        if (wr == 1) PG8_BAR;
        PG8_WAIT_V(4); PG8_BAR;
        PG8_STAGE(PG8_SB(1, 0), cB + kstep, voffB); PG8_STAGE(PG8_SA(1, 0), cA + kstep, voffA); PG8_STAGE(PG8_SB(1, 1), cB + hstep + kstep, voffB);
        PG8_WAIT_V(6); PG8_BAR;
    }
    for (;;) {
        const bool has_next = S.next(ui + 1, nxt);
        const char* nA = has_next ? (const char*)g.A + (size_t)nxt.pm * tstep : cA; const char* nB = has_next ? (const char*)g.Bt + (size_t)nxt.pn * tstep : cB;
        for (int t = 0; t < nt; t += 2) {
            const bool last = (t == nt - 2);
            const char* a1 = cA + (size_t)(t + 1) * kstep;
            const char* a2 = last ? nA : cA + (size_t)(t + 2) * kstep; const char* b2 = last ? nB : cB + (size_t)(t + 2) * kstep;
            const char* a3 = a2 + kstep; const char* b3 = b2 + kstep;
            if (last && has_next) S.a_ready(nxt);
            if constexpr (SP2) {
            PG8_LDB(B0, 0, 0); PG8_LDB(B1, 0, 1); PG8_SCHED; PG8_LDA(At, 0, 0); PG8_STAGE(PG8_SA(1, 1), a1 + hstep, voffA);
            PG8_WAIT_V(8); PG8_WAIT_L(0); PG8_BAR; PG8_MMA(0, 0, At, B0); PG8_MMA(0, 1, At, B1); PG8_BAR; PG8_SCHED;
            PG8_LDA(At, 0, 1); PG8_STAGE(PG8_SB(0, 0), b2, voffB); PG8_STAGE(PG8_SB(0, 1), b2 + hstep, voffB); PG8_STAGE(PG8_SA(0, 0), a2, voffA);
            PG8_WAIT_V(8); PG8_WAIT_L(0); PG8_BAR; PG8_MMA(1, 0, At, B0); PG8_MMA(1, 1, At, B1); PG8_BAR; PG8_SCHED;
            PG8_LDB(B0, 1, 0); PG8_LDB(B1, 1, 1); PG8_SCHED; PG8_LDA(At, 1, 0); PG8_STAGE(PG8_SA(0, 1), a2 + hstep, voffA);
            PG8_WAIT_V(8); PG8_WAIT_L(0); PG8_BAR; PG8_MMA(0, 0, At, B0); PG8_MMA(0, 1, At, B1); PG8_BAR; PG8_SCHED;
            PG8_LDA(At, 1, 1); PG8_STAGE(PG8_SB(1, 0), b3, voffB); PG8_STAGE(PG8_SB(1, 1), b3 + hstep, voffB); PG8_STAGE(PG8_SA(1, 0), a3, voffA);
            PG8_WAIT_V(8); PG8_WAIT_L(0); PG8_BAR; PG8_MMA(1, 0, At, B0); PG8_MMA(1, 1, At, B1); PG8_BAR; PG8_SCHED;
            } else {
            PG8_LDB(B0, 0, 0); PG8_SCHED; PG8_LDA(At, 0, 0); PG8_STAGE(PG8_SA(1, 1), a1 + hstep, voffA);
            PG8_WAIT_L(8); PG8_BAR; PG8_WAIT_L(0); PG8_MMA(0, 0, At, B0); PG8_BAR; PG8_SCHED;
            PG8_LDB(B1, 0, 1); PG8_STAGE(PG8_SB(0, 0), b2, voffB);
            PG8_BAR; PG8_WAIT_L(0); PG8_MMA(0, 1, At, B1); PG8_BAR;
            PG8_LDA(At, 0, 1); PG8_STAGE(PG8_SA(0, 0), a2, voffA);
            PG8_BAR; PG8_WAIT_L(0); PG8_MMA(1, 0, At, B0); PG8_BAR; PG8_SCHED;
            PG8_STAGE(PG8_SB(0, 1), b2 + hstep, voffB);
            PG8_WAIT_V(6); PG8_BAR; PG8_MMA(1, 1, At, B1); PG8_BAR;
            PG8_LDB(B0, 1, 0); PG8_SCHED; PG8_LDA(At, 1, 0); PG8_STAGE(PG8_SA(0, 1), a2 + hstep, voffA);
            PG8_WAIT_L(8); PG8_BAR; PG8_WAIT_L(0); PG8_MMA(0, 0, At, B0); PG8_BAR; PG8_SCHED;
            PG8_LDB(B1, 1, 1); PG8_STAGE(PG8_SB(1, 0), b3, voffB);
            PG8_BAR; PG8_WAIT_L(0); PG8_MMA(0, 1, At, B1); PG8_BAR;
            PG8_LDA(At, 1, 1); PG8_STAGE(PG8_SA(1, 0), a3, voffA);
            PG8_BAR; PG8_WAIT_L(0); PG8_MMA(1, 0, At, B0); PG8_BAR; PG8_SCHED;
            PG8_STAGE(PG8_SB(1, 1), b3 + hstep, voffB);
            PG8_WAIT_V(6); PG8_BAR; PG8_MMA(1, 1, At, B1); PG8_BAR;
            }
        }
        if constexpr (ALIGN_EPI) { if (wr == 0) PG8_BAR; }
        if constexpr (!Epi::AFTER_DRAIN) { E(acc, cur, wr, wc, fr, fq); S.done(cur); }
        if (!has_next) break;
#pragma unroll
        for (int a = 0; a < 2; ++a)
#pragma unroll
            for (int b = 0; b < 2; ++b)
#pragma unroll
                for (int m = 0; m < 4; ++m)
#pragma unroll
                    for (int n = 0; n < 2; ++n) acc[a][b][m][n] = (f32x4){0.f, 0.f, 0.f, 0.f};
        cur = nxt; cA = nA; cB = nB; ++ui;
        if constexpr (ALIGN_EPI) { if (wr == 1) PG8_BAR; }
    }
    PG8_WAIT_V(0);
    if constexpr (!ALIGN_EPI) { if (wr == 0) PG8_BAR; }
    PG8_BAR;
    if constexpr (Epi::AFTER_DRAIN) { E.fused(acc, cur, wr, wc, fr, fq, lds, wid, lane); S.done(cur); }
#undef PG8_SA
#undef PG8_SB
#undef PG8_STAGE
#undef PG8_LDA
#undef PG8_LDB
#undef PG8_MMA
#undef PG8_WAIT_V
#undef PG8_WAIT_L
#undef PG8_BAR
#undef PG8_SCHED
}
}
namespace cg = cooperative_groups;
#define LAS __attribute__((address_space(3)))
#define DI __device__ __forceinline__
typedef unsigned short bf16;
typedef float f32x4 __attribute__((ext_vector_type(4)));
typedef float f32x16 __attribute__((ext_vector_type(16)));
typedef short bf16x8 __attribute__((ext_vector_type(8)));
typedef unsigned u32x4 __attribute__((ext_vector_type(4)));
typedef unsigned u32x2 __attribute__((ext_vector_type(2)));

#ifndef MK_ONE_LAUNCH
#define MK_ONE_LAUNCH 1
#endif
constexpr int NPHASE = 10;
constexpr int D = 1024, MP = 16384, MS = 512, M = MP + MS, DIN = 3072, FF = 4096, NB = 136, NMOD = 6144;
constexpr float EPS = 1e-6f;
constexpr size_t MiB = 1u << 20;
constexpr size_t SZ512 = (size_t)M * 512 * 2;
constexpr size_t WS_WIN = 1 * MiB, WS_WOUT = 7 * MiB, WS_W1 = 9 * MiB, WS_W2 = 17 * MiB, WS_MOD = 25 * MiB, WS_COS = 29 * MiB, WS_SIN = 29 * MiB + 512 * 1024, WS_XN = 30 * MiB;
constexpr size_t WS_U = 63 * MiB, WS_Q = WS_U + SZ512, WS_K = WS_Q + SZ512, WS_V = WS_K + SZ512, WS_G = WS_V + SZ512, WS_MIX = WS_G + SZ512, WS_L = WS_MIX + (size_t)M * 1024 * 2, WS_H = 63 * MiB;
constexpr size_t WS_END = WS_L + 16 * MiB;
constexpr size_t WS_SH2B = 512 * 1024, WS_BIAS2 = 212 * MiB, WS_SSQ = 216 * MiB, WS_SSQS = 218 * MiB;
static_assert(WS_END <= WS_BIAS2 && WS_SSQ + (size_t)MP * 16 * 4 <= WS_SSQS, "d_ws map 2");
static_assert(WS_XN + (size_t)M * D * 2 <= WS_U && WS_H + (size_t)M * FF * 2 <= 256 * MiB && WS_END <= 256 * MiB, "d_ws map");
constexpr size_t OUT_Y = 0, OUT_CONVP = (size_t)M * D, OUT_RETP = OUT_CONVP + 8 * 30 * 512, OUT_CONVS = OUT_RETP + 8 * 8 * 4096, OUT_RETS = OUT_CONVS + 128 * 30 * 512, OUT_END = OUT_RETS + (size_t)128 * 8 * 4096;
constexpr int LDS_BYTES = 147456;

__device__ const double INV_FREQ[32] = {1.0, 0.7498942093324559, 0.5623413251903491, 0.4216965034285822, 0.31622776601683794, 0.23713737056616552, 0.1778279410038923, 0.1333521432163324, 0.1, 0.07498942093324558, 0.05623413251903491, 0.042169650342858224, 0.03162277660168379, 0.023713737056616554, 0.01778279410038923, 0.01333521432163324, 0.01, 0.007498942093324558, 0.005623413251903491, 0.004216965034285823, 0.0031622776601683794, 0.0023713737056616554, 0.0017782794100389228, 0.001333521432163324, 0.001, 0.0007498942093324559, 0.0005623413251903491, 0.00042169650342858224, 0.00031622776601683794, 0.00023713737056616554, 0.00017782794100389227, 0.0001333521432163324};
__device__ const float LOG2G[8] = {-0.04580368961312479f, -0.02272007650008353f, -0.011315313227834146f, -0.005646563141142063f, -0.0028205190623786626f, -0.0014095702546713536f, -0.0007046129765893727f, -0.0003522634716290214f};

#define LDS_WAIT() asm volatile("s_waitcnt lgkmcnt(0)" ::: "memory")
DI unsigned f2bf(float f) { unsigned u = __builtin_bit_cast(unsigned, f); return (u + 0x7fffu + ((u >> 16) & 1u)) >> 16; }
DI unsigned pk2(float lo, float hi) { return f2bf(lo) | (f2bf(hi) << 16); }
DI float bf2f(unsigned h) { return __builtin_bit_cast(float, h << 16); }
DI float bflo(unsigned w) { return __builtin_bit_cast(float, w << 16); }
DI float bfhi(unsigned w) { return __builtin_bit_cast(float, w & 0xffff0000u); }
DI float sigm(float x) { return __builtin_amdgcn_rcpf(1.0f + __expf(-x)); }
DI float ex2(float x) { return __builtin_amdgcn_exp2f(x); }
DI float wave_sum(float v) {
#pragma unroll
    for (int o = 1; o < 64; o <<= 1) v += __shfl_xor(v, o);
    return v;
}
DI float sum16(float v) { v += __shfl_xor(v, 1); v += __shfl_xor(v, 2); v += __shfl_xor(v, 4); v += __shfl_xor(v, 8); return v; }

struct Args { const float* in[21]; float* out; unsigned char* ws; int ph_lo, ph_hi; };
struct Ctx {
    LAS unsigned char* lds; int tid, lane, wave, G, bid;
    const float *xp, *xs, *cache, *state, *cp, *cs, *w_ada, *b_ada, *g_mix, *w_in, *conv_w, *conv_b, *cln_g, *cln_b, *rln_g, *rln_b, *w_out, *g_ffn, *w_ff1, *w_ff2, *g_fin;
    float* out; bf16 *Wt_in, *Wt_out, *Wt_1, *Wt_2, *XN, *U, *Q, *K, *V, *Gt, *MIX, *H; float *MOD, *cosT, *sinT, *L, *BIAS2, *SSQ, *SSQS; bf16* SH2B;
};

DI f32x4 tile16(const LAS bf16* A, int lda, const LAS bf16* Bt, int ldb, int m0, int n0, int K, int lane) {
    const int r = lane & 15, q = lane >> 4; f32x4 acc = {0.f, 0.f, 0.f, 0.f};
    const LAS bf16* ap = A + (m0 + r) * lda + q * 8; const LAS bf16* bp = Bt + (n0 + r) * ldb + q * 8;
    for (int k = 0; k < K; k += 32) { const bf16x8 a = *(const LAS bf16x8*)(ap + k); const bf16x8 b = *(const LAS bf16x8*)(bp + k); acc = __builtin_amdgcn_mfma_f32_16x16x32_bf16(a, b, acc, 0, 0, 0); }
    return acc;
}

DI int win_dest_row(int c0) {
    if (c0 < 512) return 256 * (c0 >> 7) + (c0 & 127);
    if (c0 < 1024) { const int c = c0 - 512; return 256 * (c >> 7) + 128 + (c & 127); }
    if (c0 < 2048) { const int grp = (c0 - 1024) >> 9, c = (c0 - 1024) & 511, head = c >> 6, half = (c >> 5) & 1; return 256 * (4 + 2 * grp + (head >> 2)) + 128 * half + 32 * (head & 3); }
    return c0;
}
DI void p0_transpose_item(const float* W, int K, int N, bf16* WT, bool win, LAS float* scr, int item, int lane) {
    const int nblk = N / 32, kb = item / nblk, nb = item % nblk, k0 = 64 * kb, n0 = 32 * nb;
    const int drow = win ? win_dest_row(n0) : n0;
    float tv[32];
#pragma unroll
    for (int i = 0; i < 32; ++i) tv[i] = W[(size_t)(k0 + 2 * i + (lane >> 5)) * N + n0 + (lane & 31)];
#pragma unroll
    for (int i = 0; i < 32; ++i) scr[(2 * i + (lane >> 5)) * 33 + (lane & 31)] = tv[i];
    LDS_WAIT();
    const int c = lane & 7;
#pragma unroll
    for (int j = 0; j < 4; ++j) { const int n = (lane >> 3) + 8 * j; const LAS float* s = scr + (8 * c) * 33 + n;
        u32x4 o; o.x = pk2(s[0 * 33], s[1 * 33]); o.y = pk2(s[2 * 33], s[3 * 33]); o.z = pk2(s[4 * 33], s[5 * 33]); o.w = pk2(s[6 * 33], s[7 * 33]);
        *(u32x4*)(WT + (size_t)(drow + n) * K + k0 + 8 * c) = o; }
    LDS_WAIT();
}
DI void p0_mod(const Ctx& F) {
    for (int cb = F.bid; cb < 192; cb += F.G) {
    const int n0 = 32 * cb; LAS float* OUT = (LAS float*)F.lds;
    const int r32 = F.lane & 31, hi = F.lane >> 5, k0 = F.wave * 128 + 8 * hi;
    f32x16 acc[5];
#pragma unroll
    for (int mt = 0; mt < 5; ++mt)
#pragma unroll
        for (int i = 0; i < 16; ++i) acc[mt][i] = 0.f;
    const float* crow[5];
#pragma unroll
    for (int mt = 0; mt < 5; ++mt) { const int r = mt * 32 + r32; crow[mt] = (r < 8 ? F.cp + (size_t)r * D : F.cs + (size_t)((r < NB ? r : 8) - 8) * D) + k0; }
    const bool v4 = (128 + r32) < NB;
#pragma unroll 1
    for (int kh = 0; kh < 2; ++kh) {
        float bw[4][8];
#pragma unroll
        for (int ks = 0; ks < 4; ++ks)
#pragma unroll
            for (int j = 0; j < 8; ++j) bw[ks][j] = F.w_ada[(size_t)(k0 + (kh * 4 + ks) * 16 + j) * NMOD + n0 + r32];
#pragma unroll
        for (int ks = 0; ks < 4; ++ks) {
            bf16x8 b;
#pragma unroll
            for (int j = 0; j < 8; ++j) b[j] = (short)f2bf(bw[ks][j]);
            f32x4 x0[5], x1[5];
#pragma unroll
            for (int mt = 0; mt < 5; ++mt) { x0[mt] = *(const f32x4*)(crow[mt] + (kh * 4 + ks) * 16); x1[mt] = *(const f32x4*)(crow[mt] + (kh * 4 + ks) * 16 + 4); }
#pragma unroll
            for (int mt = 0; mt < 5; ++mt) { bf16x8 a;
#pragma unroll
                for (int j = 0; j < 4; ++j) { a[j] = (short)f2bf(x0[mt][j] * sigm(x0[mt][j])); a[4 + j] = (short)f2bf(x1[mt][j] * sigm(x1[mt][j])); }
                if (mt == 4 && !v4) a = (bf16x8){0, 0, 0, 0, 0, 0, 0, 0};
                acc[mt] = __builtin_amdgcn_mfma_f32_32x32x16_bf16(a, b, acc[mt], 0, 0, 0); }
        }
    }
    for (int w = 0; w < 8; ++w) {
        if (F.wave == w) {
#pragma unroll
            for (int mt = 0; mt < 5; ++mt)
#pragma unroll
                for (int i = 0; i < 16; ++i) { const int row = mt * 32 + (i & 3) + 8 * (i >> 2) + 4 * hi; const float prev = (w == 0) ? 0.f : OUT[row * 32 + r32]; OUT[row * 32 + r32] = prev + acc[mt][i]; }
        }
        __syncthreads();
    }
    for (int i = F.tid; i < NB * 32; i += 512) { const int r = i >> 5, c = i & 31; F.MOD[(size_t)r * NMOD + n0 + c] = OUT[i] + F.b_ada[n0 + c]; }
    __syncthreads();
    }
}
constexpr int I_IN = (D / 64) * (DIN / 32), I_O = (D / 64) * (D / 32), I_1 = (D / 64) * (FF / 32), I_2 = (FF / 64) * (D / 32), NITEMS = I_IN + I_O + I_1 + I_2;
constexpr int EARLY_ITEMS = 1024;
DI void transpose_items(const Ctx& F, int first, int last, int gw, int ngw) {
    LAS float* scr = (LAS float*)(F.lds + F.wave * 16384);
    for (int it = first + gw; it < last; it += ngw) { int r = it;
        if (r < I_IN) { p0_transpose_item(F.w_in, D, DIN, F.Wt_in, true, scr, r, F.lane); continue; } r -= I_IN;
        if (r < I_O) { p0_transpose_item(F.w_out, D, D, F.Wt_out, false, scr, r, F.lane); continue; } r -= I_O;
        if (r < I_1) { p0_transpose_item(F.w_ff1, D, FF, F.Wt_1, false, scr, r, F.lane); continue; } r -= I_1;
        p0_transpose_item(F.w_ff2, FF, D, F.Wt_2, false, scr, r, F.lane); }
}
DI void p0_prologue(const Ctx& F) {
    if (F.G == 256) { if (F.bid < 192) p0_mod(F); else transpose_items(F, 0, EARLY_ITEMS, (F.bid - 192) * 8 + F.wave, 64 * 8); }
    else { p0_mod(F); transpose_items(F, 0, EARLY_ITEMS, F.bid * 8 + F.wave, F.G * 8); }
}
DI void p1_tables(const Ctx& F) {
    for (int i = F.bid * 512 + F.tid; i < 2052 * 32; i += F.G * 512) { const int p = i >> 5, d = i & 31; const double pos = p < 2048 ? (double)p : (double)(16384 + (p - 2048));
        double rev = pos * INV_FREQ[d] * 0.15915494309189535; rev -= floor(rev); const float fr = (float)rev; F.cosT[i] = __builtin_amdgcn_cosf(fr); F.sinT[i] = __builtin_amdgcn_sinf(fr); }
    for (int i = F.bid * 512 + F.tid; i < 192 * 512; i += F.G * 512) { const int r = i >> 9, k = (i & 511) * 2; unsigned w = 0u; if (r < NB) w = pk2(F.MOD[(size_t)r * NMOD + 3072 + k], F.MOD[(size_t)r * NMOD + 3072 + k + 1]); *(unsigned*)(F.SH2B + (size_t)r * D + k) = w; }
    transpose_items(F, EARLY_ITEMS, NITEMS, F.bid * 8 + F.wave, F.G * 8);
}

DI void modnorm_phase(const Ctx& F, const float* x0, const float* x1, const float* g, int sh_off, int sc_off) {
    const int gw = F.bid * 8 + F.wave, NGW = F.G * 8;
    for (int m0 = gw * 4; m0 < M; m0 += NGW * 4) {
        f32x4 v[4][4];
#pragma unroll
        for (int rr = 0; rr < 4; ++rr) { const int m = m0 + rr; const float* xrow = m < MP ? x0 + (size_t)m * D : x1 + (size_t)(m - MP) * D; const f32x4* xr = (const f32x4*)xrow + F.lane;
#pragma unroll
            for (int j = 0; j < 4; ++j) v[rr][j] = xr[64 * j]; }
#pragma unroll
        for (int rr = 0; rr < 4; ++rr) { const int m = m0 + rr; const float* mod = F.MOD + (size_t)pg8::bidx_of_row(m) * NMOD; float s = 0.f;
#pragma unroll
            for (int j = 0; j < 4; ++j) s += (v[rr][j].x * v[rr][j].x + v[rr][j].y * v[rr][j].y) + (v[rr][j].z * v[rr][j].z + v[rr][j].w * v[rr][j].w);
            const float rstd = 1.0f / sqrtf(wave_sum(s) * (1.f / D) + EPS);
            u32x2* o8 = (u32x2*)(F.XN + (size_t)m * D) + F.lane;
#pragma unroll
            for (int j = 0; j < 4; ++j) { const f32x4 gv = ((const f32x4*)g)[F.lane + 64 * j], sh = ((const f32x4*)(mod + sh_off))[F.lane + 64 * j], sc = ((const f32x4*)(mod + sc_off))[F.lane + 64 * j];
                const f32x4 y = v[rr][j] * rstd * gv * (sc + 1.0f) + sh; u32x2 w; w.x = pk2(y.x, y.y); w.y = pk2(y.z, y.w); o8[64 * j] = w; } }
    }
}
DI void final_norm_phase(const Ctx& F) {
    const int gw = F.bid * 8 + F.wave, NGW = F.G * 8;
    f32x4 gf[4];
#pragma unroll
    for (int j = 0; j < 4; ++j) gf[j] = ((const f32x4*)F.g_fin)[F.lane + 64 * j];
    for (int m0 = gw * 4; m0 < M; m0 += NGW * 4) {
        f32x4 v[4][4];
#pragma unroll
        for (int rr = 0; rr < 4; ++rr) { f32x4* xr = (f32x4*)(F.out + (size_t)(m0 + rr) * D) + F.lane;
#pragma unroll
            for (int j = 0; j < 4; ++j) v[rr][j] = xr[64 * j]; }
#pragma unroll
        for (int rr = 0; rr < 4; ++rr) { f32x4* xr = (f32x4*)(F.out + (size_t)(m0 + rr) * D) + F.lane; float s = 0.f;
#pragma unroll
            for (int j = 0; j < 4; ++j) s += (v[rr][j].x * v[rr][j].x + v[rr][j].y * v[rr][j].y) + (v[rr][j].z * v[rr][j].z + v[rr][j].w * v[rr][j].w);
            const float rstd = 1.0f / sqrtf(wave_sum(s) * (1.f / D) + EPS);
#pragma unroll
            for (int j = 0; j < 4; ++j) xr[64 * j] = v[rr][j] * rstd * gf[j]; }
    }
}

DI void ret_local_unit(const Ctx& F, int uid) {
    const int b = uid >> 7, h = (uid >> 4) & 7, n = uid & 15, row0 = b * 2048 + n * 128; const float lg = LOG2G[h];
    LAS bf16* KT = (LAS bf16*)F.lds; LAS bf16* VT = (LAS bf16*)(F.lds + 17408);
    { const int j = F.tid >> 2, d0 = (F.tid & 3) * 16; const float f = ex2(lg * (float)(127 - j));
      const u32x4* kp = (const u32x4*)(F.K + (size_t)(row0 + j) * 512 + h * 64 + d0); const u32x4* vp = (const u32x4*)(F.V + (size_t)(row0 + j) * 512 + h * 64 + d0);
      const u32x4 k0 = kp[0], k1 = kp[1], v0 = vp[0], v1 = vp[1];
#pragma unroll
      for (int e = 0; e < 4; ++e) {
          KT[(d0 + 2 * e) * 136 + j] = (bf16)f2bf(bflo(k0[e]) * f); KT[(d0 + 2 * e + 1) * 136 + j] = (bf16)f2bf(bfhi(k0[e]) * f);
          KT[(d0 + 8 + 2 * e) * 136 + j] = (bf16)f2bf(bflo(k1[e]) * f); KT[(d0 + 8 + 2 * e + 1) * 136 + j] = (bf16)f2bf(bfhi(k1[e]) * f);
          VT[(d0 + 2 * e) * 136 + j] = (bf16)(v0[e] & 0xffffu); VT[(d0 + 2 * e + 1) * 136 + j] = (bf16)(v0[e] >> 16);
          VT[(d0 + 8 + 2 * e) * 136 + j] = (bf16)(v1[e] & 0xffffu); VT[(d0 + 8 + 2 * e + 1) * 136 + j] = (bf16)(v1[e] >> 16); } }
    __syncthreads();
    const int r = F.lane & 15, q = F.lane >> 4;
#pragma unroll
    for (int t2 = 0; t2 < 2; ++t2) { const int t = 2 * F.wave + t2, m0 = (t >> 2) * 16, n0 = (t & 3) * 16; const f32x4 acc = tile16(KT, 136, VT, 136, m0, n0, 128, F.lane);
#pragma unroll
        for (int i = 0; i < 4; ++i) F.L[(size_t)uid * 4096 + (m0 + 4 * q + i) * 64 + n0 + r] = acc[i]; }
    __syncthreads();
}
DI void conv_ln_store(const Ctx& F, const LAS float* dwrow, bf16* dst) {
    const f32x4 a = *(const LAS f32x4*)(dwrow + F.lane * 8), b = *(const LAS f32x4*)(dwrow + F.lane * 8 + 4);
    const float mean = wave_sum((a.x + a.y) + (a.z + a.w) + (b.x + b.y) + (b.z + b.w)) * (1.f / 512);
    const f32x4 da = a - mean, db = b - mean;
    const float var = wave_sum((da.x * da.x + da.y * da.y) + (da.z * da.z + da.w * da.w) + (db.x * db.x + db.y * db.y) + (db.z * db.z + db.w * db.w)) * (1.f / 512);
    const float rstd = 1.0f / sqrtf(var + EPS);
    const f32x4 g0 = *(const f32x4*)(F.cln_g + F.lane * 8), g1 = *(const f32x4*)(F.cln_g + F.lane * 8 + 4), b0 = *(const f32x4*)(F.cln_b + F.lane * 8), b1 = *(const f32x4*)(F.cln_b + F.lane * 8 + 4);
    f32x4 y0 = da * rstd * g0 + b0, y1 = db * rstd * g1 + b1;
#pragma unroll
    for (int e = 0; e < 4; ++e) { y0[e] = y0[e] * sigm(y0[e]); y1[e] = y1[e] * sigm(y1[e]); }
    u32x4 w; w.x = pk2(y0[0], y0[1]); w.y = pk2(y0[2], y0[3]); w.z = pk2(y1[0], y1[1]); w.w = pk2(y1[2], y1[3]);
    *(u32x4*)(dst + F.lane * 8) = w;
}
DI void conv_prompt_unit(const Ctx& F, int cid, const float (&w)[31], float bias) {
    const int b = cid >> 6, t0 = (cid & 63) * 32, ch = F.tid;
    LAS bf16* Us = (LAS bf16*)F.lds; LAS float* DW = (LAS float*)(F.lds + 63488);
    for (int c = F.tid; c < 62 * 64; c += 512) { const int row = c >> 6, cc = c & 63, t = t0 - 30 + row; u32x4 v = {0u, 0u, 0u, 0u};
        if (t >= 0) v = *(const u32x4*)(F.U + (size_t)(b * 2048 + t) * 512 + cc * 8);
        *(LAS u32x4*)(Us + row * 512 + cc * 8) = v; }
    __syncthreads();
#pragma unroll 1
    for (int tb = 0; tb < 4; ++tb) { float acc[8];
#pragma unroll
        for (int o = 0; o < 8; ++o) acc[o] = bias;
#pragma unroll
        for (int jj = 0; jj < 38; ++jj) { const float x = bf2f(Us[(tb * 8 + jj) * 512 + ch]);
#pragma unroll
            for (int o = 0; o < 8; ++o) { const int j = jj - o; if (j >= 0 && j < 31) acc[o] += w[j] * x; } }
#pragma unroll
        for (int o = 0; o < 8; ++o) DW[(tb * 8 + o) * 512 + ch] = acc[o]; }
    if (t0 == 2016) {
#pragma unroll 1
        for (int i = 0; i < 30; ++i) F.out[OUT_CONVP + (size_t)(b * 30 + i) * 512 + ch] = bf2f(Us[(32 + i) * 512 + ch]); }
    __syncthreads();
#pragma unroll 1
    for (int i = 0; i < 4; ++i) { const int tt = F.wave + 8 * i; conv_ln_store(F, DW + tt * 512, F.MIX + (size_t)(b * 2048 + t0 + tt) * 1024); }
    __syncthreads();
}
DI void conv_sample_unit(const Ctx& F, int bs, const float (&w)[31], float bias) {
    const int ch = F.tid; LAS float* DW = (LAS float*)F.lds;
    float ext[34];
#pragma unroll
    for (int i = 0; i < 30; ++i) ext[i] = F.cache[(size_t)(bs * 30 + i) * 512 + ch];
#pragma unroll
    for (int t = 0; t < 4; ++t) ext[30 + t] = bf2f(F.U[(size_t)(MP + bs * 4 + t) * 512 + ch]);
#pragma unroll
    for (int t = 0; t < 4; ++t) { float a = bias;
#pragma unroll
        for (int j = 0; j < 31; ++j) a += w[j] * ext[t + j];
        DW[t * 512 + ch] = a; }
#pragma unroll
    for (int i = 0; i < 30; ++i) F.out[OUT_CONVS + (size_t)(bs * 30 + i) * 512 + ch] = ext[4 + i];
    __syncthreads();
    if (F.wave < 4) conv_ln_store(F, DW + F.wave * 512, F.MIX + (size_t)(MP + bs * 4 + F.wave) * 1024);
    __syncthreads();
}
DI void ret_sample_unit(const Ctx& F, int unit) {
    const int bs = unit >> 3, h = unit & 7, rowb = MP + bs * 4, lane = F.lane; const float lg = LOG2G[h];
    LAS float* QT = (LAS float*)(F.lds + F.wave * 2048); LAS float* KT = QT + 256;
    float qv[4], kv[4], vv[4];
#pragma unroll
    for (int i = 0; i < 4; ++i) { const size_t o = (size_t)(rowb + i) * 512 + h * 64 + lane; qv[i] = bf2f(F.Q[o]); kv[i] = bf2f(F.K[o]); vv[i] = bf2f(F.V[o]); QT[lane * 4 + i] = qv[i]; KT[lane * 4 + i] = kv[i]; }
    LDS_WAIT();
    const float g1 = ex2(lg), g2 = ex2(2.f * lg), g3 = ex2(3.f * lg), g4 = ex2(4.f * lg);
    const float gp[4] = {1.0f, g1, g2, g3};
    float A[4][4];
#pragma unroll
    for (int i = 0; i < 4; ++i)
#pragma unroll
        for (int j = 0; j < 4; ++j) A[i][j] = (j <= i) ? wave_sum(qv[i] * kv[j]) * gp[i - j] : 0.f;
    float cross[4] = {0.f, 0.f, 0.f, 0.f};
    const float* S0 = F.state + (size_t)(bs * 8 + h) * 4096 + lane; float* S1 = F.out + OUT_RETS + (size_t)(bs * 8 + h) * 4096 + lane;
    const float kv0 = g3 * vv[0], kv1 = g2 * vv[1], kv2 = g1 * vv[2], kv3 = vv[3];
#pragma unroll 8
    for (int d = 0; d < 64; ++d) { const float s = S0[d * 64]; const f32x4 qd = *(const LAS f32x4*)(QT + d * 4), kd = *(const LAS f32x4*)(KT + d * 4);
        cross[0] += qd[0] * s; cross[1] += qd[1] * s; cross[2] += qd[2] * s; cross[3] += qd[3] * s;
        S1[d * 64] = g4 * s + kd[0] * kv0 + kd[1] * kv1 + kd[2] * kv2 + kd[3] * kv3; }
    const float gq[4] = {g1, g2, g3, g4};
    const float lng = F.rln_g[h * 64 + lane], lnb = F.rln_b[h * 64 + lane];
#pragma unroll
    for (int i = 0; i < 4; ++i) { float o = gq[i] * cross[i];
#pragma unroll
        for (int j = 0; j < 4; ++j) if (j <= i) o += A[i][j] * vv[j];
        const float mean = wave_sum(o) * (1.f / 64), dl = o - mean, var = wave_sum(dl * dl) * (1.f / 64);
        float y = dl * (1.0f / sqrtf(var + EPS)) * lng + lnb; y *= bf2f(F.Gt[(size_t)(rowb + i) * 512 + h * 64 + lane]);
        F.MIX[(size_t)(rowb + i) * 1024 + 512 + h * 64 + lane] = (bf16)f2bf(y); }
    LDS_WAIT();
}
DI void p3a_phase(const Ctx& F) {
    for (int u = F.bid; u < 1024; u += F.G) ret_local_unit(F, u);
    float w[31];
#pragma unroll
    for (int j = 0; j < 31; ++j) w[j] = F.conv_w[j * 512 + F.tid];
    const float bias = F.conv_b[F.tid];
    for (int c = F.bid; c < 512; c += F.G) conv_prompt_unit(F, c, w, bias);
    const int nconv_wg = F.G >= 256 ? 128 : F.G / 2;
    if (F.bid < nconv_wg) { for (int bs = F.bid; bs < 128; bs += nconv_wg) conv_sample_unit(F, bs, w, bias); }
    else { const int nw = (F.G - nconv_wg) * 8; for (int un = (F.bid - nconv_wg) * 8 + F.wave; un < 1024; un += nw) ret_sample_unit(F, un); }
}
DI void ret_out_quad(const Ctx& F, int qd) {
    const int bh = qd >> 2, n0 = 4 * (qd & 3), b = bh >> 3, h = bh & 7; const float lg = LOG2G[h], gC = ex2(lg * 128.f);
    LAS bf16* Qs = (LAS bf16*)F.lds; LAS bf16* Ks = (LAS bf16*)(F.lds + 18432); LAS bf16* Vt = (LAS bf16*)(F.lds + 36864); LAS bf16* PA = (LAS bf16*)(F.lds + 62464);
    const int j = F.tid >> 2, d0 = (F.tid & 3) * 16, e0 = F.tid * 8, sd = F.tid >> 3, dv0 = (F.tid & 7) * 8;
    const int r = F.lane & 15, q = F.lane >> 4, w = F.wave;
    const float* Lb = F.L + (size_t)bh * 16 * 4096 + e0;
    f32x4 s0 = {0.f, 0.f, 0.f, 0.f}, s1 = {0.f, 0.f, 0.f, 0.f};
    { f32x4 la[12], lb[12];
#pragma unroll
      for (int m = 0; m < 12; ++m) { if (m < n0) { la[m] = *(const f32x4*)(Lb + (size_t)m * 4096); lb[m] = *(const f32x4*)(Lb + (size_t)m * 4096 + 4); } else { la[m] = (f32x4){0.f, 0.f, 0.f, 0.f}; lb[m] = (f32x4){0.f, 0.f, 0.f, 0.f}; } }
#pragma unroll
      for (int m = 0; m < 12; ++m) { if (m < n0) { s0 = s0 * gC + la[m]; s1 = s1 * gC + lb[m]; } } }
    size_t go = (size_t)(b * 2048 + n0 * 128 + j) * 512 + h * 64 + d0;
    u32x4 q0 = ((const u32x4*)(F.Q + go))[0], q1 = ((const u32x4*)(F.Q + go))[1], k0 = ((const u32x4*)(F.K + go))[0], k1 = ((const u32x4*)(F.K + go))[1], v0 = ((const u32x4*)(F.V + go))[0], v1 = ((const u32x4*)(F.V + go))[1];
    f32x4 ln0 = *(const f32x4*)(Lb + (size_t)n0 * 4096), ln1 = *(const f32x4*)(Lb + (size_t)n0 * 4096 + 4);
    float lng[4], lnb[4];
#pragma unroll
    for (int ct = 0; ct < 4; ++ct) { lng[ct] = F.rln_g[h * 64 + 16 * ct + r]; lnb[ct] = F.rln_b[h * 64 + 16 * ct + r]; }
    const float fq = ex2(lg * (float)(j + 1));
#pragma unroll 1
    for (int ci = 0; ci < 4; ++ci) {
        const int n = n0 + ci, row0 = b * 2048 + n * 128;
        *(LAS u32x4*)(Qs + j * 72 + d0) = q0; *(LAS u32x4*)(Qs + j * 72 + d0 + 8) = q1; *(LAS u32x4*)(Ks + j * 72 + d0) = k0; *(LAS u32x4*)(Ks + j * 72 + d0 + 8) = k1;
        { u32x4 a0, a1;
#pragma unroll
          for (int e = 0; e < 4; ++e) { a0[e] = pk2(bflo(q0[e]) * fq, bfhi(q0[e]) * fq); a1[e] = pk2(bflo(q1[e]) * fq, bfhi(q1[e]) * fq); }
          *(LAS u32x4*)(PA + j * 200 + 128 + d0) = a0; *(LAS u32x4*)(PA + j * 200 + 128 + d0 + 8) = a1; }
#pragma unroll
        for (int e = 0; e < 4; ++e) {
            Vt[(d0 + 2 * e) * 200 + j] = (bf16)(v0[e] & 0xffffu); Vt[(d0 + 2 * e + 1) * 200 + j] = (bf16)(v0[e] >> 16);
            Vt[(d0 + 8 + 2 * e) * 200 + j] = (bf16)(v1[e] & 0xffffu); Vt[(d0 + 8 + 2 * e + 1) * 200 + j] = (bf16)(v1[e] >> 16); }
#pragma unroll
        for (int e = 0; e < 4; ++e) { Vt[(dv0 + e) * 200 + 128 + sd] = (bf16)f2bf(s0[e]); Vt[(dv0 + 4 + e) * 200 + 128 + sd] = (bf16)f2bf(s1[e]); }
        s0 = s0 * gC + ln0; s1 = s1 * gC + ln1;
        if (n == 15) { float* rp = F.out + OUT_RETP + (size_t)bh * 4096 + e0; *(f32x4*)rp = s0; *(f32x4*)(rp + 4) = s1; }
        __syncthreads();
        if (ci < 3) {
            go += (size_t)128 * 512;
            q0 = ((const u32x4*)(F.Q + go))[0]; q1 = ((const u32x4*)(F.Q + go))[1]; k0 = ((const u32x4*)(F.K + go))[0]; k1 = ((const u32x4*)(F.K + go))[1]; v0 = ((const u32x4*)(F.V + go))[0]; v1 = ((const u32x4*)(F.V + go))[1];
            ln0 = *(const f32x4*)(Lb + (size_t)(n + 1) * 4096); ln1 = *(const f32x4*)(Lb + (size_t)(n + 1) * 4096 + 4); }
        bf16 gv[4][4];
#pragma unroll
        for (int i = 0; i < 4; ++i)
#pragma unroll
            for (int ct = 0; ct < 4; ++ct) gv[i][ct] = F.Gt[(size_t)(row0 + 16 * w + 4 * q + i) * 512 + h * 64 + 16 * ct + r];
        for (int jt = 0; jt < 8; ++jt) {
            if (jt <= w) { const f32x4 acc = tile16(Qs, 72, Ks, 72, 16 * w, 16 * jt, 64, F.lane);
#pragma unroll
                for (int i = 0; i < 4; ++i) { const int ii = 16 * w + 4 * q + i, jj = 16 * jt + r; const float p = (ii >= jj) ? acc[i] * ex2(lg * (float)(ii - jj)) : 0.f; PA[ii * 200 + jj] = (bf16)f2bf(p); } }
            else {
#pragma unroll
                for (int i = 0; i < 4; ++i) PA[(16 * w + 4 * q + i) * 200 + 16 * jt + r] = (bf16)0; }
        }
        __syncthreads();
        f32x4 o[4];
#pragma unroll
        for (int ct = 0; ct < 4; ++ct) o[ct] = tile16(PA, 200, Vt, 200, 16 * w, 16 * ct, 192, F.lane);
#pragma unroll
        for (int i = 0; i < 4; ++i) { const int row = row0 + 16 * w + 4 * q + i;
            const float mean = sum16((o[0][i] + o[1][i]) + (o[2][i] + o[3][i])) * (1.f / 64);
            const float c0 = o[0][i] - mean, c1 = o[1][i] - mean, c2 = o[2][i] - mean, c3 = o[3][i] - mean;
            const float rstd = 1.0f / sqrtf(sum16((c0 * c0 + c1 * c1) + (c2 * c2 + c3 * c3)) * (1.f / 64) + EPS);
            const float dd[4] = {c0, c1, c2, c3};
#pragma unroll
            for (int ct = 0; ct < 4; ++ct) { float y = dd[ct] * rstd * lng[ct] + lnb[ct]; y *= bf2f(gv[i][ct]); F.MIX[(size_t)row * 1024 + 512 + h * 64 + 16 * ct + r] = (bf16)f2bf(y); } }
        __syncthreads();
    }
}

template <int NKS>
DI void small_partials(const Ctx& F, const bf16* A, int lda, int arow0, const bf16* Bt, int ldb, int brow0, int brow1) {
    const int r = F.lane & 15, q = F.lane >> 4, kw0 = F.wave * NKS * 32;
    const bf16* ap = A + (size_t)(arow0 + r) * lda + kw0 + 8 * q; const bf16* b0p = Bt + (size_t)(brow0 + r) * ldb + kw0 + 8 * q; const bf16* b1p = Bt + (size_t)(brow1 + r) * ldb + kw0 + 8 * q;
    f32x4 acc[4][2];
#pragma unroll
    for (int rt = 0; rt < 4; ++rt) { acc[rt][0] = (f32x4){0.f, 0.f, 0.f, 0.f}; acc[rt][1] = (f32x4){0.f, 0.f, 0.f, 0.f}; }
#pragma unroll 1
    for (int kb = 0; kb < NKS; kb += 4) {
        bf16x8 a[4][4], b[4][2];
#pragma unroll
        for (int ks = 0; ks < 4; ++ks) {
#pragma unroll
            for (int rt = 0; rt < 4; ++rt) a[ks][rt] = *(const bf16x8*)(ap + (size_t)rt * 16 * lda + (kb + ks) * 32);
            b[ks][0] = *(const bf16x8*)(b0p + (kb + ks) * 32); b[ks][1] = *(const bf16x8*)(b1p + (kb + ks) * 32); }
#pragma unroll
        for (int ks = 0; ks < 4; ++ks)
#pragma unroll
            for (int rt = 0; rt < 4; ++rt) { acc[rt][0] = __builtin_amdgcn_mfma_f32_16x16x32_bf16(a[ks][rt], b[ks][0], acc[rt][0], 0, 0, 0); acc[rt][1] = __builtin_amdgcn_mfma_f32_16x16x32_bf16(a[ks][rt], b[ks][1], acc[rt][1], 0, 0, 0); }
    }
    LAS float* P = (LAS float*)F.lds + F.wave * 64 * 33;
#pragma unroll
    for (int rt = 0; rt < 4; ++rt)
#pragma unroll
        for (int ct = 0; ct < 2; ++ct)
#pragma unroll
            for (int i = 0; i < 4; ++i) P[(16 * rt + 4 * q + i) * 33 + 16 * ct + r] = acc[rt][ct][i];
    __syncthreads();
}
DI float red_sum(const Ctx& F, int row, int col) { const LAS float* P = (const LAS float*)F.lds + row * 33 + col; float s = 0.f;
#pragma unroll
    for (int w = 0; w < 8; ++w) s += P[w * 64 * 33];
    return s; }
DI void small_in_unit(const Ctx& F, int id) {
    const int ru = id & 7, cu = id >> 3, pn = cu >> 3, o = 16 * (cu & 7);
    small_partials<4>(F, F.XN, D, MP + 64 * ru, F.Wt_in, D, 256 * pn + o, 256 * pn + 128 + o);
    const int row = F.tid >> 3, c = (F.tid & 7) * 2, r = MP + 64 * ru + row;
    const float a0 = red_sum(F, row, c), a1 = red_sum(F, row, c + 1), b0 = red_sum(F, row, 16 + c), b1 = red_sum(F, row, 16 + c + 1);
    if (pn < 4) { *(unsigned*)(F.U + (size_t)r * 512 + 128 * pn + o + c) = pk2(a0 * sigm(b0), a1 * sigm(b1)); }
    else if (pn < 8) { const bool isq = pn < 6; bf16* base = isq ? F.Q : F.K; const float sc = isq ? 0.125f : 1.0f; const int d = (o & 31) + c, head = 4 * ((pn - 4) & 1) + (o >> 5), pi = pg8::posidx_of_row(r);
        const float c0 = F.cosT[pi * 32 + d], c1 = F.cosT[pi * 32 + d + 1], s0 = F.sinT[pi * 32 + d], s1 = F.sinT[pi * 32 + d + 1];
        *(unsigned*)(base + (size_t)r * 512 + head * 64 + d) = pk2((a0 * c0 - b0 * s0) * sc, (a1 * c1 - b1 * s1) * sc);
        *(unsigned*)(base + (size_t)r * 512 + head * 64 + 32 + d) = pk2((a0 * s0 + b0 * c0) * sc, (a1 * s1 + b1 * c1) * sc); }
    else { const bool isg = pn >= 10; bf16* base = isg ? F.Gt : F.V; const int col = 256 * ((pn - 8) & 1) + o + c;
        float v0 = a0, v1 = a1, w0 = b0, w1 = b1; if (isg) { v0 *= sigm(v0); v1 *= sigm(v1); w0 *= sigm(w0); w1 *= sigm(w1); }
        *(unsigned*)(base + (size_t)r * 512 + col) = pk2(v0, v1); *(unsigned*)(base + (size_t)r * 512 + col + 128) = pk2(w0, w1); }
    __syncthreads();
}
template <int NKS, bool WITHZ>
DI void small_res_unit(const Ctx& F, int id, const bf16* A, int lda, const bf16* Bt, const float* xs, const float* gate) {
    const int ru = id & 7, cu = id >> 3;
    small_partials<NKS>(F, A, lda, MP + 64 * ru, Bt, lda, 32 * cu, 32 * cu + 16);
    const int row = F.tid >> 3, c = (F.tid & 7) * 2, rs = 64 * ru + row, r = MP + rs; const float* mr = F.MOD + (size_t)pg8::bidx_of_row(r) * NMOD; const float* gr = gate + (size_t)pg8::bidx_of_row(r) * NMOD;
    float q = 0.f;
#pragma unroll
    for (int t = 0; t < 2; ++t) { const int col = 32 * cu + 16 * t + c; const float v0 = red_sum(F, row, 16 * t + c), v1 = red_sum(F, row, 16 * t + c + 1);
        const float x0 = xs[(size_t)rs * D + col] + gr[col] * v0, x1 = xs[(size_t)rs * D + col + 1] + gr[col + 1] * v1;
        F.out[(size_t)r * D + col] = x0; F.out[(size_t)r * D + col + 1] = x1;
        if (WITHZ) { q += x0 * x0 + x1 * x1; *(unsigned*)(F.XN + (size_t)r * D + col) = pk2(x0 * F.g_ffn[col] * (1.0f + mr[4096 + col]), x1 * F.g_ffn[col + 1] * (1.0f + mr[4096 + col + 1])); } }
    if (WITHZ) { q += __shfl_xor(q, 1); q += __shfl_xor(q, 2); q += __shfl_xor(q, 4); if ((F.tid & 7) == 0) F.SSQS[rs * 32 + cu] = q; }
    __syncthreads();
}
DI void small_ff1_unit(const Ctx& F, int id) {
    const int ru = id & 7, cu = id >> 3;
    small_partials<4>(F, F.XN, D, MP + 64 * ru, F.Wt_1, D, 32 * cu, 32 * cu + 16);
    const int row = F.tid >> 3, c = (F.tid & 7) * 2, rs = 64 * ru + row, r = MP + rs; const float* br = F.BIAS2 + (size_t)pg8::bidx_of_row(r) * FF;
    float tot = 0.f;
#pragma unroll
    for (int i = 0; i < 8; ++i) { const f32x4 s4 = *(const f32x4*)(F.SSQS + rs * 32 + 4 * i); tot += (s4[0] + s4[1]) + (s4[2] + s4[3]); }
    const float rstd = 1.0f / sqrtf(tot * (1.f / D) + EPS);
#pragma unroll
    for (int t = 0; t < 2; ++t) { const int col = 32 * cu + 16 * t + c; const float v0 = fmaxf(red_sum(F, row, 16 * t + c) * rstd + br[col], 0.f), v1 = fmaxf(red_sum(F, row, 16 * t + c + 1) * rstd + br[col + 1], 0.f);
        *(unsigned*)(F.H + (size_t)r * FF + col) = pk2(v0 * v0, v1 * v1); }
    __syncthreads();
}
DI void bias2_unit(const Ctx& F, int id) {
    const int ru = id % 3, cu = id / 3;
    small_partials<4>(F, F.SH2B, D, 64 * ru, F.Wt_1, D, 32 * cu, 32 * cu + 16);
    const int row = F.tid >> 3, c = (F.tid & 7) * 2;
#pragma unroll
    for (int t = 0; t < 2; ++t) { const int col = 32 * cu + 16 * t + c; F.BIAS2[(size_t)(64 * ru + row) * FF + col] = red_sum(F, row, 16 * t + c); F.BIAS2[(size_t)(64 * ru + row) * FF + col + 1] = red_sum(F, row, 16 * t + c + 1); }
    __syncthreads();
}

#define XB_TMO      128
#define XB_XCNT(j)  (256  + 64 * (j))
#define XB_XSUB(j)  (1280 + 64 * (j))
#define XB_XGEN(j)  (2304 + 64 * (j))
#define XB_TOP      3328
#define XB_TOPGEN   3392
#define XCD_BAR_WORDS 3456
#define XB_SPIN_CAP (1u << 18)

__device__ __forceinline__ unsigned xb_ld(unsigned* p)              { return __hip_atomic_load(p, __ATOMIC_RELAXED, __HIP_MEMORY_SCOPE_AGENT); }
__device__ __forceinline__ unsigned xb_add(unsigned* p, unsigned v) { return __hip_atomic_fetch_add(p, v, __ATOMIC_RELAXED, __HIP_MEMORY_SCOPE_AGENT); }
__device__ __forceinline__ unsigned xb_xcc_id() { return (unsigned)__builtin_amdgcn_s_getreg((3 << 11) | 20) & 0xFu; }
#define XB_SPIN(cond, bar) do { unsigned _sp = 0; while (cond) { __builtin_amdgcn_s_sleep(1); \
    if ((++_sp & 255u) == 0u) { if (xb_ld(&(bar)[XB_TMO])) break; if (_sp > XB_SPIN_CAP) { atomicAdd(&(bar)[XB_TMO], 1u); break; } } } } while (0)

struct XcdBarrier {
    unsigned* bar; unsigned x;
    volatile LAS unsigned* st;
};

__device__ __forceinline__ XcdBarrier xcd_barrier_post(unsigned* bar, volatile LAS unsigned* st) {
    XcdBarrier b; b.bar = bar; b.x = xb_xcc_id(); b.st = st;
    if (threadIdx.x == 0) (void)xb_add(&bar[XB_XCNT(b.x)], 1u);
    return b;
}
__device__ __forceinline__ void xcd_barrier_complete(unsigned* bar, unsigned x, unsigned& nloc, unsigned& nx) {
    const unsigned G = gridDim.x * gridDim.y * gridDim.z;
    unsigned sum, cnt, mine, sp = 0u;
    for (;;) {
        sum = 0u; cnt = 0u; mine = 0u;
#pragma unroll
        for (unsigned j = 0; j < 16; ++j) { const unsigned c = xb_ld(&bar[XB_XCNT(j)]); sum += c; cnt += (c > 0u) ? 1u : 0u; mine = (j == x) ? c : mine; }
        if (sum == G) break;
        __builtin_amdgcn_s_sleep(1);
        if ((++sp & 255u) == 0u) { if (xb_ld(&bar[XB_TMO])) break; if (sp > XB_SPIN_CAP) { atomicAdd(&bar[XB_TMO], 1u); break; } }
    }
    nloc = mine > 0u ? mine : 1u; nx = cnt > 0u ? cnt : 1u;
}

__device__ __forceinline__ void xcd_barrier(const XcdBarrier& b) {
    asm volatile("s_waitcnt vmcnt(0)" ::: "memory");
    __syncthreads();
    if (threadIdx.x == 0) {
        unsigned* bar = b.bar;
        __builtin_amdgcn_s_waitcnt(0);
        unsigned nloc = b.st[0], nx = b.st[1];
        if (nloc == 0u) { xcd_barrier_complete(bar, b.x, nloc, nx); b.st[0] = nloc; b.st[1] = nx; }
        const unsigned old = xb_add(&bar[XB_XSUB(b.x)], 1u);
        const unsigned gen = old / nloc;
        if (old + 1u == (gen + 1u) * nloc) {
            __builtin_amdgcn_fence(__ATOMIC_RELEASE, "agent");
            asm volatile("s_waitcnt vmcnt(0)" ::: "memory");
            const unsigned og = xb_add(&bar[XB_TOP], 1u);
            const unsigned tg = og / nx;
            if (og + 1u == (tg + 1u) * nx) xb_add(&bar[XB_TOPGEN], 1u);
            else XB_SPIN(xb_ld(&bar[XB_TOPGEN]) == tg, bar);
            __builtin_amdgcn_fence(__ATOMIC_ACQUIRE, "agent");
            xb_add(&bar[XB_XGEN(b.x)], 1u);
            asm volatile("s_waitcnt vmcnt(0)" ::: "memory");
        } else {
            XB_SPIN(xb_ld(&bar[XB_XGEN(b.x)]) == gen, bar);
            __builtin_amdgcn_fence(__ATOMIC_ACQUIRE, "agent");
            asm volatile("s_waitcnt vmcnt(0)" ::: "memory");
        }
    }
    __syncthreads();
}

__global__ void __launch_bounds__(512, 2) fwd_kernel(Args a) {
    extern __shared__ __attribute__((aligned(16))) unsigned char lds_raw[];
    Ctx F;
    F.lds = (LAS unsigned char*)lds_raw; F.tid = threadIdx.x; F.lane = F.tid & 63; F.wave = __builtin_amdgcn_readfirstlane(F.tid >> 6); F.G = gridDim.x; F.bid = blockIdx.x;
    F.xp = a.in[0]; F.xs = a.in[1]; F.cache = a.in[2]; F.state = a.in[3]; F.cp = a.in[4]; F.cs = a.in[5]; F.w_ada = a.in[6]; F.b_ada = a.in[7]; F.g_mix = a.in[8]; F.w_in = a.in[9]; F.conv_w = a.in[10]; F.conv_b = a.in[11];
    F.cln_g = a.in[12]; F.cln_b = a.in[13]; F.rln_g = a.in[14]; F.rln_b = a.in[15]; F.w_out = a.in[16]; F.g_ffn = a.in[17]; F.w_ff1 = a.in[18]; F.w_ff2 = a.in[19]; F.g_fin = a.in[20];
    F.out = a.out; unsigned char* ws = a.ws;
    F.Wt_in = (bf16*)(ws + WS_WIN); F.Wt_out = (bf16*)(ws + WS_WOUT); F.Wt_1 = (bf16*)(ws + WS_W1); F.Wt_2 = (bf16*)(ws + WS_W2); F.MOD = (float*)(ws + WS_MOD); F.cosT = (float*)(ws + WS_COS); F.sinT = (float*)(ws + WS_SIN);
    F.XN = (bf16*)(ws + WS_XN); F.U = (bf16*)(ws + WS_U); F.Q = (bf16*)(ws + WS_Q); F.K = (bf16*)(ws + WS_K); F.V = (bf16*)(ws + WS_V); F.Gt = (bf16*)(ws + WS_G); F.MIX = (bf16*)(ws + WS_MIX); F.L = (float*)(ws + WS_L); F.H = (bf16*)(ws + WS_H); F.BIAS2 = (float*)(ws + WS_BIAS2); F.SSQ = (float*)(ws + WS_SSQ); F.SSQS = (float*)(ws + WS_SSQS); F.SH2B = (bf16*)(ws + WS_SH2B);
    if (F.tid < 8) ((volatile LAS unsigned*)(F.lds + 131072 + 64))[F.tid] = 0u;
    __syncthreads();
    XcdBarrier bar = xcd_barrier_post((unsigned*)ws, (volatile LAS unsigned*)(F.lds + 131072 + 64));
    const int lo = a.ph_lo, hi = a.ph_hi;
    if (hi > 1000) cg::this_grid().sync();
#define IN(k) (lo <= (k) && (k) < hi)
#define SEAM(k) do { if (IN(k) && IN((k) + 1)) xcd_barrier(bar); } while (0)
#ifndef PROBE_MASK
#define PROBE_MASK 0
#endif
#define REP(k) for (int rep_ = 0; rep_ < (((PROBE_MASK >> (k)) & 1) ? 2 : 1); ++rep_, (rep_ < (((PROBE_MASK >> (k)) & 1) ? 2 : 1) ? xcd_barrier(bar) : (void)0))
    if (IN(0)) REP(0) { p0_prologue(F); } SEAM(0);
#ifdef PROBE_SYNCS
    for (int i_ = 0; i_ < PROBE_SYNCS; ++i_) xcd_barrier(bar);
#endif
    if (IN(1)) REP(1) { p1_tables(F); modnorm_phase(F, F.xp, F.xs, F.g_mix, 0, 1024); } SEAM(1);
    if (IN(2)) REP(2) { pg8::Gemm g{F.XN, F.Wt_in, MP, DIN, D}; pg8::StaticOrder S; S.init(MP, DIN, F.G, F.bid); pg8::EpiIn E{F.U, F.Q, F.K, F.V, F.Gt, F.cosT, F.sinT};
        pg8::gemm_phase<pg8::EpiIn, pg8::StaticOrder, true, true>(F.lds, g, S, E);
        for (int id = F.bid; id < 768; id += F.G) small_in_unit(F, id); } SEAM(2);
#if defined(PROBE_DUPG) && (PROBE_DUPG == 2)
    xcd_barrier(bar);
    if (IN(2)) REP(2) { pg8::Gemm g{F.XN, F.Wt_in, MP, DIN, D}; pg8::StaticOrder S; S.init(MP, DIN, F.G, F.bid); pg8::EpiIn E{F.U, F.Q, F.K, F.V, F.Gt, F.cosT, F.sinT};
        pg8::gemm_phase<pg8::EpiIn, pg8::StaticOrder, true, true>(F.lds, g, S, E);
        for (int id = F.bid; id < 768; id += F.G) small_in_unit(F, id); }
    xcd_barrier(bar);
#endif
    if (IN(3)) REP(3) { p3a_phase(F); } SEAM(3);
    if (IN(4)) REP(4) { for (int qd = F.bid; qd < 256; qd += F.G) ret_out_quad(F, qd); } SEAM(4);
    if (IN(5)) REP(5) { pg8::Gemm g{F.MIX, F.Wt_out, MP, D, D}; pg8::StaticOrder S; S.init(MP, D, F.G, F.bid); pg8::EpiOutZ E{F.xp, F.out, F.MOD, F.g_ffn, F.XN, F.SSQ};
        pg8::gemm_phase<pg8::EpiOutZ, pg8::StaticOrder, true, true>(F.lds, g, S, E);
        for (int id = F.bid; id < 256; id += F.G) small_res_unit<4, true>(F, id, F.MIX, D, F.Wt_out, F.xs, F.MOD + 2048);
        for (int id = F.bid; id < 384; id += F.G) bias2_unit(F, id); }
    if (IN(5) && IN(7)) xcd_barrier(bar);
#if defined(PROBE_DUPG) && (PROBE_DUPG == 5)
    xcd_barrier(bar);
    if (IN(5)) REP(5) { pg8::Gemm g{F.MIX, F.Wt_out, MP, D, D}; pg8::StaticOrder S; S.init(MP, D, F.G, F.bid); pg8::EpiOutZ E{F.xp, F.out, F.MOD, F.g_ffn, F.XN, F.SSQ};
        pg8::gemm_phase<pg8::EpiOutZ, pg8::StaticOrder, true, true>(F.lds, g, S, E);
        for (int id = F.bid; id < 256; id += F.G) small_res_unit<4, true>(F, id, F.MIX, D, F.Wt_out, F.xs, F.MOD + 2048);
        for (int id = F.bid; id < 384; id += F.G) bias2_unit(F, id); }
    xcd_barrier(bar);
#endif
    if (IN(7)) REP(7) { pg8::Gemm g{F.XN, F.Wt_1, MP, FF, D}; pg8::StaticOrder S; S.init(MP, FF, F.G, F.bid); pg8::EpiFF1 E{F.H, F.SSQ, F.BIAS2};
        pg8::gemm_phase<pg8::EpiFF1, pg8::StaticOrder, true, true>(F.lds, g, S, E);
        for (int id = F.bid; id < 1024; id += F.G) small_ff1_unit(F, id); } SEAM(7);
#if defined(PROBE_DUPG) && (PROBE_DUPG == 7)
    xcd_barrier(bar);
    if (IN(7)) REP(7) { pg8::Gemm g{F.XN, F.Wt_1, MP, FF, D}; pg8::StaticOrder S; S.init(MP, FF, F.G, F.bid); pg8::EpiFF1 E{F.H, F.SSQ, F.BIAS2};
        pg8::gemm_phase<pg8::EpiFF1, pg8::StaticOrder, true, true>(F.lds, g, S, E);
        for (int id = F.bid; id < 1024; id += F.G) small_ff1_unit(F, id); }
    xcd_barrier(bar);
#endif
    if (IN(8)) REP(8) { pg8::Gemm g{F.H, F.Wt_2, MP, D, FF}; pg8::StaticOrder S; S.init(MP, D, F.G, F.bid); pg8::EpiRes E{F.out, F.out + (size_t)MP * D, F.out, F.MOD + 5120};
        pg8::gemm_phase<pg8::EpiRes, pg8::StaticOrder, true, true>(F.lds, g, S, E);
        for (int id = F.bid; id < 256; id += F.G) small_res_unit<16, false>(F, id, F.H, FF, F.Wt_2, F.out + (size_t)MP * D, F.MOD + 5120); } SEAM(8);
    if (IN(9)) REP(9) { final_norm_phase(F); }
#undef IN
#undef SEAM
}

extern "C" void kernel_launch(void* const* d_in, const int* in_sizes, int n_in, void* d_out, int out_size, void* d_ws, size_t ws_size, hipStream_t stream) {
    static int grid = 0;
    if (grid == 0) {
        if (n_in != 21 || (size_t)out_size != OUT_END || ws_size < WS_END) { fprintf(stderr, "kernel_launch: unexpected shapes: n_in %d out %d ws %zu\n", n_in, out_size, ws_size); grid = -1; return; }
        int dev = 0, cus = 0, per_cu = 0;
        (void)hipGetDevice(&dev); (void)hipDeviceGetAttribute(&cus, hipDeviceAttributeMultiprocessorCount, dev);
        if (hipFuncSetAttribute((const void*)fwd_kernel, hipFuncAttributeMaxDynamicSharedMemorySize, LDS_BYTES) != hipSuccess) { fprintf(stderr, "kernel_launch: hipFuncSetAttribute failed\n"); grid = -1; return; }
        if (hipOccupancyMaxActiveBlocksPerMultiprocessor(&per_cu, (const void*)fwd_kernel, 512, LDS_BYTES) != hipSuccess || per_cu < 1) { fprintf(stderr, "kernel_launch: occupancy query says %d\n", per_cu); per_cu = 1; }
        (void)hipGetLastError();
        grid = cus * per_cu;
    }
    if (grid < 0) return;
    if (hipMemsetAsync(d_ws, 0, 16384, stream) != hipSuccess) { fprintf(stderr, "kernel_launch: hipMemsetAsync failed\n"); return; }
    Args a{};
    for (int i = 0; i < 21; ++i) a.in[i] = (const float*)d_in[i];
    a.out = (float*)d_out; a.ws = (unsigned char*)d_ws;
#if MK_ONE_LAUNCH
    a.ph_lo = 0; a.ph_hi = NPHASE;
    void* args[] = {&a};
    hipError_t e = hipLaunchCooperativeKernel((const void*)fwd_kernel, dim3(grid), dim3(512), args, LDS_BYTES, stream);
    if (e != hipSuccess) fprintf(stderr, "cooperative launch failed: %s (grid %d)\n", hipGetErrorString(e), grid);
#else
    for (int p = 0; p < NPHASE; ++p) { a.ph_lo = p; a.ph_hi = p + 1; hipLaunchKernelGGL(fwd_kernel, dim3(grid), dim3(512), LDS_BYTES, stream, a); }
#endif
}
```
